# Optimizing an MI355X kernel written in HIP

```python
import jax, jax.numpy as jnp
from jax import lax
import numpy as np

D_MODEL = 1024
BATCH = 4
SEQ = 8192
DEPTH = 4

HEAD_DIM = 64
HEADS_MLA = 4
HEADS_DIL = 8
HEADS_DSA = 4
D_MIX = (HEADS_MLA + HEADS_DIL + HEADS_DSA) * HEAD_DIM
Q_LORA = 256
KV_LORA = 128
MLA_NOPE = 64
MLA_ROPE = 32
MLA_V = HEAD_DIM
DIL_PAIRS = ((128, 1), (512, 4), (2048, 16))
IDX_HEADS = 8
IDX_DIM = 32
DSA_TOPK = 256
D_FF = 2816
CONV_WIDTH = 3
ROPE_THETA = 500000.0
ROT_FRAC = 4
BLOCK = 128
NORM_EPS = 1e-6
DIL_PAD = 16 * BLOCK
IN_SPLITS = (Q_LORA, KV_LORA, MLA_ROPE,
             3 * HEADS_DIL * HEAD_DIM,
             3 * HEADS_DSA * HEAD_DIM,
             IDX_HEADS * IDX_DIM, IDX_DIM, IDX_HEADS)
N_IN = sum(IN_SPLITS)

kernel_name = "hybrid_mla_dilated_dsa_convffn"


def rms_norm(x, g):
    xf = x.astype(jnp.float32)
    y = xf * lax.rsqrt(jnp.mean(xf * xf, axis=-1, keepdims=True) + NORM_EPS)
    return (y * g.astype(jnp.float32)).astype(x.dtype)


def rope_tables(seq, dim):
    inv = jnp.power(jnp.float32(ROPE_THETA), -jnp.arange(0, dim, 2, dtype=jnp.float32) / dim)
    ang = jnp.arange(seq, dtype=jnp.float32)[:, None] * inv[None, :]
    return jnp.cos(ang), jnp.sin(ang)


def apply_rope(x, cos, sin):
    h = x.shape[-1] // 2
    xf = x.astype(jnp.float32)
    x1, x2 = xf[..., :h], xf[..., h:]
    c, s = cos[None, :, None, :], sin[None, :, None, :]
    return jnp.concatenate([x1 * c - x2 * s, x2 * c + x1 * s], axis=-1).astype(x.dtype)


def partial_rope(x, cos, sin):
    r = 2 * cos.shape[-1]
    return jnp.concatenate([apply_rope(x[..., :r], cos, sin), x[..., r:]], axis=-1)


def mla_attention(c_q, c_kv, k_pe_raw, g_q, w_uq, g_kv, w_ukv, cos_a, sin_a):
    B, S, _ = c_q.shape
    q = (rms_norm(c_q, g_q) @ w_uq).reshape(B, S, HEADS_MLA, MLA_NOPE + MLA_ROPE)
    q_nope = q[..., :MLA_NOPE]
    q_pe = apply_rope(q[..., MLA_NOPE:], cos_a, sin_a)
    kv = (rms_norm(c_kv, g_kv) @ w_ukv).reshape(B, S, HEADS_MLA, MLA_NOPE + MLA_V)
    k_nope, v = kv[..., :MLA_NOPE], kv[..., MLA_NOPE:]
    k_pe = apply_rope(k_pe_raw[:, :, None, :], cos_a, sin_a)[:, :, 0]
    scale = (MLA_NOPE + MLA_ROPE) ** -0.5
    nb = S // BLOCK
    qn_b = q_nope.reshape(B, nb, BLOCK, HEADS_MLA, MLA_NOPE).transpose(1, 0, 2, 3, 4)
    qp_b = q_pe.reshape(B, nb, BLOCK, HEADS_MLA, MLA_ROPE).transpose(1, 0, 2, 3, 4)
    kpos = jnp.arange(S)

    def block(args):
        qn, qp, i = args
        s = (jnp.einsum('bqhe,bshe->bhqs', qn, k_nope).astype(jnp.float32)
             + jnp.einsum('bqhr,bsr->bhqs', qp, k_pe).astype(jnp.float32)) * scale
        qpos = i * BLOCK + jnp.arange(BLOCK)
        s = jnp.where((kpos[None, :] <= qpos[:, None])[None, None], s, -jnp.inf)
        p = jax.nn.softmax(s, axis=-1).astype(v.dtype)
        return jnp.einsum('bhqs,bshe->bqhe', p, v)

    o = lax.map(block, (qn_b, qp_b, jnp.arange(nb)))
    return o.transpose(1, 0, 2, 3, 4).reshape(B, S, HEADS_MLA, MLA_V)


def dilated_window(q, k, v, dilation, n_win):
    B, Sp, H, Dh = q.shape
    n = Sp // dilation
    nb = n // BLOCK

    def stride_split(t):
        return t.reshape(B, n, dilation, H, Dh).transpose(0, 2, 1, 3, 4)

    qs, ks, vs = stride_split(q), stride_split(k), stride_split(v)
    qb = qs.reshape(B, dilation, nb, BLOCK, H, Dh)

    def band(t):
        tp = jnp.pad(t, ((0, 0), (0, 0), (BLOCK, 0), (0, 0), (0, 0)))
        prev = tp[:, :, :n].reshape(B, dilation, nb, BLOCK, H, Dh)
        return jnp.concatenate([prev, t.reshape(B, dilation, nb, BLOCK, H, Dh)], axis=3)

    kb, vb = band(ks), band(vs)
    s = jnp.einsum('bdnqhe,bdnkhe->bdnhqk', qb, kb).astype(jnp.float32) * (Dh ** -0.5)
    qi = jnp.arange(BLOCK)[None, :, None]
    kj = jnp.arange(2 * BLOCK)[None, None, :]
    blk = jnp.arange(nb)[:, None, None]
    dist = BLOCK + qi - kj
    valid = (dist >= 0) & (dist <= n_win) & ((blk > 0) | (kj >= BLOCK))
    s = jnp.where(valid[None, None, :, None], s, -jnp.inf)
    m = jnp.max(s, axis=-1, keepdims=True)
    p = jnp.exp(s - m)
    l = jnp.sum(p, axis=-1, keepdims=True)
    o = jnp.einsum('bdnhqk,bdnkhe->bdnqhe', p / l, vb.astype(jnp.float32))
    o = o.reshape(B, dilation, n, H, Dh).transpose(0, 2, 1, 3, 4).reshape(B, Sp, H, Dh)

    def stat_back(t):
        t = t[..., 0].transpose(0, 1, 2, 4, 3).reshape(B, dilation, n, H)
        return t.transpose(0, 2, 1, 3).reshape(B, Sp, H)

    return o, stat_back(m), stat_back(l)


def dilated_attention(q, k, v):
    B, S, H, Dh = q.shape
    Sp = -(-S // DIL_PAD) * DIL_PAD
    pad = ((0, 0), (0, Sp - S), (0, 0), (0, 0))
    qp, kp, vp = jnp.pad(q, pad), jnp.pad(k, pad), jnp.pad(v, pad)
    os_, ms, ls = [], [], []
    for window, dil in DIL_PAIRS:
        o, m, l = dilated_window(qp, kp, vp, dil, window // dil)
        os_.append(o); ms.append(m); ls.append(l)
    m_all = jnp.stack(ms)
    a = jnp.stack(ls) * jnp.exp(m_all - jnp.max(m_all, axis=0))
    o = jnp.einsum('pbsh,pbshe->bshe', a, jnp.stack(os_)) / jnp.sum(a, axis=0)[..., None]
    return o[:, :S].astype(q.dtype)


def dsa_attention(q, k, v, q_idx, k_idx, w_idx):
    B, S, H, Dh = q.shape
    k_sel = min(DSA_TOPK, S // 4)
    nb = S // BLOCK
    idx_scale = (IDX_HEADS * IDX_DIM) ** -0.5
    kpos = jnp.arange(S)

    def to_blocks(t):
        return t.reshape((B, nb, BLOCK) + t.shape[2:]).swapaxes(0, 1)

    def block(args):
        qb, qib, wib, i = args
        qpos = i * BLOCK + jnp.arange(BLOCK)
        causal = kpos[None, :] <= qpos[:, None]
        dots = jnp.einsum('bqhd,bsd->bqhs', qib, k_idx).astype(jnp.float32)
        score = jnp.einsum('bqhs,bqh->bqs', jax.nn.relu(dots), wib.astype(jnp.float32) * idx_scale)
        score = jnp.where(causal[None], score, -jnp.inf)
        _, sel = lax.top_k(score, k_sel)
        flat = sel.reshape(B, BLOCK * k_sel)
        kg = jax.vmap(lambda a, j: a[j])(k, flat).reshape(B, BLOCK, k_sel, H, Dh)
        vg = jax.vmap(lambda a, j: a[j])(v, flat).reshape(B, BLOCK, k_sel, H, Dh)
        s = jnp.einsum('bqhe,bqkhe->bhqk', qb, kg).astype(jnp.float32) * (Dh ** -0.5)
        ok = sel <= qpos[None, :, None]
        s = jnp.where(ok[:, None], s, -jnp.inf)
        p = jax.nn.softmax(s, axis=-1).astype(v.dtype)
        return jnp.einsum('bhqk,bqkhe->bqhe', p, vg)

    o = lax.map(block, (to_blocks(q), to_blocks(q_idx), to_blocks(w_idx), jnp.arange(nb)))
    return o.swapaxes(0, 1).reshape(B, S, H, Dh)


def causal_dwconv(u, w, b):
    K = w.shape[0]
    S = u.shape[1]
    up = jnp.pad(u, ((0, 0), (K - 1, 0), (0, 0)))
    y = up[:, 0:S] * w[0]
    for j in range(1, K):
        y = y + up[:, j:j + S] * w[j]
    return y + b


def setup_inputs(seed: int = 0) -> dict:
    key = jax.random.key(seed)
    ks = jax.random.split(key, 16)
    f32 = jnp.float32

    def nrm(k, shape, scale):
        return jax.random.normal(k, shape, f32) * scale

    def gain(k, shape):
        return 1.0 + 0.02 * jax.random.normal(k, shape, f32)

    L = DEPTH
    return {
        "x": nrm(ks[0], (BATCH, SEQ, D_MODEL), 1.0),
        "g_attn": gain(ks[1], (L, D_MODEL)),
        "w_in": nrm(ks[2], (L, D_MODEL, N_IN), D_MODEL ** -0.5),
        "g_q_lat": gain(ks[3], (L, Q_LORA)),
        "w_uq": nrm(ks[4], (L, Q_LORA, HEADS_MLA * (MLA_NOPE + MLA_ROPE)), Q_LORA ** -0.5),
        "g_kv_lat": gain(ks[5], (L, KV_LORA)),
        "w_ukv": nrm(ks[6], (L, KV_LORA, HEADS_MLA * (MLA_NOPE + MLA_V)), KV_LORA ** -0.5),
        "w_o": nrm(ks[7], (L, D_MIX, D_MODEL), D_MIX ** -0.5),
        "g_ffn": gain(ks[8], (L, D_MODEL)),
        "w_up": nrm(ks[9], (L, D_MODEL, 2 * D_FF), D_MODEL ** -0.5),
        "conv_w": nrm(ks[10], (L, CONV_WIDTH, 2 * D_FF), CONV_WIDTH ** -0.5),
        "conv_b": nrm(ks[11], (L, 2 * D_FF), 0.01),
        "w_down": nrm(ks[12], (L, D_FF, D_MODEL), D_FF ** -0.5),
        "g_final": gain(ks[13], (D_MODEL,)),
    }


def reference(x, g_attn, w_in, g_q_lat, w_uq, g_kv_lat, w_ukv, w_o,
              g_ffn, w_up, conv_w, conv_b, w_down, g_final):
    B, S, _ = x.shape
    cos_a, sin_a = rope_tables(S, MLA_ROPE)
    cos_h, sin_h = rope_tables(S, HEAD_DIM // ROT_FRAC)
    cos_i, sin_i = rope_tables(S, IDX_DIM // ROT_FRAC)
    offsets = np.cumsum(IN_SPLITS)[:-1].tolist()
    for l in range(DEPTH):
        h = rms_norm(x, g_attn[l])
        z = h @ w_in[l]
        c_q, c_kv, k_pe, z_dil, z_dsa, z_qi, z_ki, z_wi = jnp.split(z, offsets, axis=-1)

        o_a = mla_attention(c_q, c_kv, k_pe, g_q_lat[l], w_uq[l], g_kv_lat[l], w_ukv[l], cos_a, sin_a)

        qkv_b = z_dil.reshape(B, S, 3, HEADS_DIL, HEAD_DIM)
        o_b = dilated_attention(partial_rope(qkv_b[:, :, 0], cos_h, sin_h),
                                partial_rope(qkv_b[:, :, 1], cos_h, sin_h),
                                qkv_b[:, :, 2])

        qkv_c = z_dsa.reshape(B, S, 3, HEADS_DSA, HEAD_DIM)
        q_idx = partial_rope(z_qi.reshape(B, S, IDX_HEADS, IDX_DIM), cos_i, sin_i)
        k_idx = partial_rope(z_ki[:, :, None, :], cos_i, sin_i)[:, :, 0]
        o_c = dsa_attention(partial_rope(qkv_c[:, :, 0], cos_h, sin_h),
                            partial_rope(qkv_c[:, :, 1], cos_h, sin_h),
                            qkv_c[:, :, 2], q_idx, k_idx, z_wi)

        mix = jnp.concatenate([o_a.reshape(B, S, -1), o_b.reshape(B, S, -1),
                               o_c.reshape(B, S, -1)], axis=-1)
        x = x + mix @ w_o[l]

        h = rms_norm(x, g_ffn[l])
        u = causal_dwconv(h @ w_up[l], conv_w[l], conv_b[l])
        gate, up = u[..., :D_FF], u[..., D_FF:]
        x = x + (jax.nn.silu(gate) * up) @ w_down[l]
    return rms_norm(x, g_final)
```

```cpp
#include <hip/hip_runtime.h>
#include <stdint.h>

#define DI __device__ __forceinline__
typedef unsigned short bf16_t;
typedef short bf16x8 __attribute__((ext_vector_type(8)));
typedef float f32x4 __attribute__((ext_vector_type(4)));
typedef unsigned long long u64;

constexpr int NB = 4, S = 8192, D = 1024, NL = 4, M = NB * S;
constexpr int NIN = 3016, NINP = 3072, DFF = 2816, NUP = 2 * DFF;
constexpr float EPS = 1e-6f;
constexpr float LOG2E = 1.4426950408889634f;
constexpr float THETA = 500000.0f;

DI bf16_t f2bf(float f) { unsigned u = __float_as_uint(f); u += 0x7fffu + ((u >> 16) & 1u); return (bf16_t)(u >> 16); }
DI float bf2f(bf16_t h) { return __uint_as_float(((unsigned)h) << 16); }

constexpr size_t MiB = 1u << 20;
constexpr size_t OFF_CTL = 0;
constexpr size_t OFF_TAB = 1 * MiB;
constexpr size_t OFF_RS = 3 * MiB;
constexpr size_t OFF_W = 8 * MiB;
constexpr size_t OFF_XB = 108 * MiB;
constexpr size_t OFF_MIX = 172 * MiB;
constexpr size_t OFF_Z = 236 * MiB;

constexpr size_t W_IN = (size_t)NINP * D, W_UQ = 512 * 256, W_UKV = 512 * 128, W_O = (size_t)D * D, W_UP = (size_t)NUP * D, W_DN = (size_t)D * DFF;
constexpr size_t W_LAYER = W_IN + W_UQ + W_UKV + W_O + W_UP + W_DN;
static_assert(OFF_W + W_LAYER * NL * 2 <= OFF_XB, "weights fit");

struct Bufs {
    float* X;
    bf16_t* XB;
    float* RS;
    float* RQ; float* RKV;
    float *cosA, *sinA, *cosH, *sinH, *cosI, *sinI;
    bf16_t* W;
    bf16_t* MIX;
    bf16_t *QM, *VM, *CQ, *CKV, *KM, *DQ, *DK, *DV, *SQ, *SK, *SV, *QI, *KI; float* WI;
    char* Z;
    char* SCRA;
};

static Bufs make_bufs(void* d_out, void* d_ws) {
    Bufs B{}; char* ws = (char*)d_ws;
    B.X = (float*)d_out; B.XB = (bf16_t*)(ws + OFF_XB);
    float* rs = (float*)(ws + OFF_RS); B.RS = rs; B.RQ = rs + M; B.RKV = rs + 2 * M;
    float* tab = (float*)(ws + OFF_TAB);
    B.cosA = tab; B.sinA = tab + S * 16; B.cosH = tab + S * 32; B.sinH = tab + S * 40; B.cosI = tab + S * 48; B.sinI = tab + S * 52;
    B.W = (bf16_t*)(ws + OFF_W); B.MIX = (bf16_t*)(ws + OFF_MIX);
    char* z = ws + OFF_Z; B.Z = z; B.SCRA = ws + OFF_MIX;
    size_t o = 0;
    B.QM = (bf16_t*)(z + o); o += (size_t)M * 4 * 96 * 2;
    B.VM = (bf16_t*)(z + o); o += (size_t)M * 4 * 64 * 2;
    B.CQ = (bf16_t*)(z + o); o += (size_t)M * 256 * 2;
    B.CKV = (bf16_t*)(z + o); o += (size_t)M * 128 * 2;
    B.KM = (bf16_t*)(z + o); o += (size_t)M * 4 * 96 * 2;
    B.DQ = (bf16_t*)(z + o); o += (size_t)M * 512 * 2;
    B.DK = (bf16_t*)(z + o); o += (size_t)M * 512 * 2;
    B.DV = (bf16_t*)(z + o); o += (size_t)M * 512 * 2;
    B.SQ = (bf16_t*)(z + o); o += (size_t)M * 256 * 2;
    B.SK = (bf16_t*)(z + o); o += (size_t)M * 256 * 2;
    B.SV = (bf16_t*)(z + o); o += (size_t)M * 256 * 2;
    B.QI = (bf16_t*)(z + o); o += (size_t)M * 256 * 2;
    B.KI = (bf16_t*)(z + o); o += (size_t)M * 32 * 2;
    B.WI = (float*)(z + o); o += (size_t)M * 8 * 4;
    return B;
}

DI float wave_sum(float v) {
#pragma unroll
    for (int o = 32; o > 0; o >>= 1) v += __shfl_xor(v, o);
    return v;
}
DI float wave_max(float v) {
#pragma unroll
    for (int o = 32; o > 0; o >>= 1) v = fmaxf(v, __shfl_xor(v, o));
    return v;
}
DI float block_sum_256(float v, float* sh) {
    v = wave_sum(v);
    __syncthreads();
    if ((threadIdx.x & 63) == 0) sh[threadIdx.x >> 6] = v;
    __syncthreads();
    return sh[0] + sh[1] + sh[2] + sh[3];
}

__global__ void k_tables(Bufs B) {
    const int t = blockIdx.x, i = threadIdx.x;
    if (i < 16) { const float inv = powf(THETA, -(float)(2 * i) / 32.0f); const float a = (float)t * inv; B.cosA[t * 16 + i] = cosf(a); B.sinA[t * 16 + i] = sinf(a); }
    else if (i < 24) { const int j = i - 16; const float inv = powf(THETA, -(float)(2 * j) / 16.0f); const float a = (float)t * inv; B.cosH[t * 8 + j] = cosf(a); B.sinH[t * 8 + j] = sinf(a); }
    else if (i < 28) { const int j = i - 24; const float inv = powf(THETA, -(float)(2 * j) / 8.0f); const float a = (float)t * inv; B.cosI[t * 4 + j] = cosf(a); B.sinI[t * 4 + j] = sinf(a); }
}

DI int src_in(int n, int perm) {
    if (n >= NIN) return -1;
    if (!perm) return n;
    const int g = n & ~31, ch = (n >> 2) & 7, e = n & 3;
    if (n >= 384 && n < 416) return g + 4 * ((ch >> 1) + 4 * (ch & 1)) + e;
    bool rh = false;
    if (n >= 416 && n < 416 + 1024) rh = (((n - 416) & 63) < 32);
    else if (n >= 1952 && n < 1952 + 512) rh = (((n - 1952) & 63) < 32);
    if (rh) { const int sc = (ch == 1) ? 2 : (ch == 2 ? 1 : ch); return g + 4 * sc + e; }
    return n;
}
DI int src_col(int kind, int n, int perm) {
    switch (kind) {
        case 0: return src_in(n, perm);
        case 1: return n < 384 ? n : -1;
        case 4: if (!perm) return n; else { const int pn = n >> 8, j = n & 255; return j < 128 ? 128 * pn + j : DFF + 128 * pn + (j - 128); }
        default: return n;
    }
}
__global__ void __launch_bounds__(256) k_wconv(const float* W, const float* gain, bf16_t* out, int K, int Nsrc, int Npad, int kind, int perm) {
    __shared__ float tile[32][33];
    const int n0 = blockIdx.x * 32, k0 = blockIdx.y * 32, tx = threadIdx.x & 31, ty = threadIdx.x >> 5;
    const int sc = src_col(kind, n0 + tx, perm);
#pragma unroll
    for (int i = 0; i < 4; ++i) { const int k = k0 + ty + 8 * i; float v = 0.f; if (sc >= 0) v = W[(size_t)k * Nsrc + sc] * (gain ? gain[k] : 1.f); tile[ty + 8 * i][tx] = v; }
    __syncthreads();
#pragma unroll
    for (int i = 0; i < 4; ++i) { const int n = n0 + ty + 8 * i; out[(size_t)n * K + k0 + tx] = f2bf(tile[tx][ty + 8 * i]); }
}

__global__ void __launch_bounds__(256) k_prep_x(const float* x, Bufs B) {
    __shared__ float sh[4];
    const size_t row = blockIdx.x; const int tid = threadIdx.x;
    const f32x4 v = *(const f32x4*)(x + row * D + tid * 4);
    *(f32x4*)(B.X + row * D + tid * 4) = v;
    bf16_t* xb = B.XB + row * D + tid * 4;
    xb[0] = f2bf(v[0]); xb[1] = f2bf(v[1]); xb[2] = f2bf(v[2]); xb[3] = f2bf(v[3]);
    const float ss = block_sum_256(v[0] * v[0] + v[1] * v[1] + v[2] * v[2] + v[3] * v[3], sh);
    if (tid == 0) B.RS[row] = rsqrtf(ss / (float)D + EPS);
}

__global__ void __launch_bounds__(256) k_gemm_naive(const bf16_t* A, const bf16_t* Bt, float* C, int K, int ldc) {
    __shared__ __attribute__((aligned(16))) bf16_t sA[128 * 40];
    __shared__ __attribute__((aligned(16))) bf16_t sB[128 * 40];
    const int tid = threadIdx.x, wid = tid >> 6, lane = tid & 63, wr = wid >> 1, wc = wid & 1, fr = lane & 15, fq = lane >> 4;
    const int row0 = blockIdx.y * 128, col0 = blockIdx.x * 128, lr = tid >> 1, lh = tid & 1;
    f32x4 acc[4][4];
#pragma unroll
    for (int i = 0; i < 4; ++i)
#pragma unroll
        for (int j = 0; j < 4; ++j) acc[i][j] = (f32x4){0.f, 0.f, 0.f, 0.f};
    const bf16_t* ap = A + (size_t)(row0 + lr) * K + lh * 16;
    const bf16_t* bp = Bt + (size_t)(col0 + lr) * K + lh * 16;
    for (int k0 = 0; k0 < K; k0 += 32) {
        const uint4 a0 = *(const uint4*)(ap + k0), a1 = *(const uint4*)(ap + k0 + 8);
        const uint4 b0 = *(const uint4*)(bp + k0), b1 = *(const uint4*)(bp + k0 + 8);
        __syncthreads();
        *(uint4*)(sA + lr * 40 + lh * 16) = a0; *(uint4*)(sA + lr * 40 + lh * 16 + 8) = a1;
        *(uint4*)(sB + lr * 40 + lh * 16) = b0; *(uint4*)(sB + lr * 40 + lh * 16 + 8) = b1;
        __syncthreads();
        bf16x8 af[4], bf[4];
#pragma unroll
        for (int i = 0; i < 4; ++i) af[i] = *(const bf16x8*)(sA + (wr * 64 + i * 16 + fr) * 40 + fq * 8);
#pragma unroll
        for (int j = 0; j < 4; ++j) bf[j] = *(const bf16x8*)(sB + (wc * 64 + j * 16 + fr) * 40 + fq * 8);
#pragma unroll
        for (int i = 0; i < 4; ++i)
#pragma unroll
            for (int j = 0; j < 4; ++j) acc[i][j] = __builtin_amdgcn_mfma_f32_16x16x32_bf16(af[i], bf[j], acc[i][j], 0, 0, 0);
    }
#pragma unroll
    for (int i = 0; i < 4; ++i)
#pragma unroll
        for (int j = 0; j < 4; ++j)
#pragma unroll
            for (int r = 0; r < 4; ++r) C[(size_t)(row0 + wr * 64 + i * 16 + fq * 4 + r) * ldc + col0 + wc * 64 + j * 16 + fr] = acc[i][j][r];
}

__global__ void __launch_bounds__(256) k_inproj_post(const float* ZRAW, int b, Bufs B) {
    __shared__ float sh[4];
    const int t = blockIdx.x, tid = threadIdx.x; const size_t row = (size_t)b * S + t;
    const float rs = B.RS[row];
    const float* zr = ZRAW + (size_t)t * NINP;
#define Z(c) (zr[(c)] * rs)
    { const float v = Z(tid); B.CQ[row * 256 + tid] = f2bf(v); const float ss = block_sum_256(v * v, sh); if (tid == 0) B.RQ[row] = rsqrtf(ss / 256.f + EPS); }
    { float v = 0.f; if (tid < 128) { v = Z(256 + tid); B.CKV[row * 128 + tid] = f2bf(v); } const float ss = block_sum_256(v * v, sh); if (tid == 0) B.RKV[row] = rsqrtf(ss / 128.f + EPS); }
    if (tid < 16) { const int j = tid; const float x1 = Z(384 + j), x2 = Z(384 + 16 + j), c = B.cosA[t * 16 + j], s = B.sinA[t * 16 + j];
        const bf16_t o1 = f2bf(x1 * c - x2 * s), o2 = f2bf(x2 * c + x1 * s);
        for (int h = 0; h < 4; ++h) { B.KM[(row * 4 + h) * 96 + 64 + j] = o1; B.KM[(row * 4 + h) * 96 + 80 + j] = o2; } }
    for (int idx = tid; idx < 1536; idx += 256) {
        const int which = idx / 512, hd = (idx % 512) / 64, d = idx % 64; float v = Z(416 + idx);
        if (which < 2 && d < 16) { const int j = d & 7; const float x1 = Z(416 + idx - d + j), x2 = Z(416 + idx - d + j + 8), c = B.cosH[t * 8 + j], s = B.sinH[t * 8 + j]; v = d < 8 ? x1 * c - x2 * s : x2 * c + x1 * s; }
        if (which == 0) v *= 0.125f * LOG2E;
        bf16_t* dst = which == 0 ? B.DQ : (which == 1 ? B.DK : B.DV); dst[(row * 8 + hd) * 64 + d] = f2bf(v);
    }
    for (int idx = tid; idx < 768; idx += 256) {
        const int which = idx / 256, hd = (idx % 256) / 64, d = idx % 64; float v = Z(1952 + idx);
        if (which < 2 && d < 16) { const int j = d & 7; const float x1 = Z(1952 + idx - d + j), x2 = Z(1952 + idx - d + j + 8), c = B.cosH[t * 8 + j], s = B.sinH[t * 8 + j]; v = d < 8 ? x1 * c - x2 * s : x2 * c + x1 * s; }
        if (which == 0) v *= 0.125f * LOG2E;
        bf16_t* dst = which == 0 ? B.SQ : (which == 1 ? B.SK : B.SV); dst[(row * 4 + hd) * 64 + d] = f2bf(v);
    }
    { const int idx = tid, d = idx % 32; float v = Z(2720 + idx);
      if (d < 8) { const int j = d & 3; const float x1 = Z(2720 + idx - d + j), x2 = Z(2720 + idx - d + j + 4), c = B.cosI[t * 4 + j], s = B.sinI[t * 4 + j]; v = d < 4 ? x1 * c - x2 * s : x2 * c + x1 * s; }
      B.QI[row * 256 + idx] = f2bf(v); }
    if (tid < 32) { const int d = tid; float v = Z(2976 + d);
      if (d < 8) { const int j = d & 3; const float x1 = Z(2976 + j), x2 = Z(2976 + j + 4), c = B.cosI[t * 4 + j], s = B.sinI[t * 4 + j]; v = d < 4 ? x1 * c - x2 * s : x2 * c + x1 * s; }
      B.KI[row * 32 + d] = f2bf(v); }
    if (tid < 8) B.WI[row * 8 + tid] = Z(3008 + tid) * 0.0625f;
#undef Z
}

__global__ void __launch_bounds__(256) k_mlaup_post(const float* QRAW, const float* KVRAW, int b, Bufs B) {
    const int t = blockIdx.x, tid = threadIdx.x; const size_t row = (size_t)b * S + t;
    const float rq = B.RQ[row], rkv = B.RKV[row];
    const float* qr = QRAW + (size_t)t * 512; const float* kr = KVRAW + (size_t)t * 512;
    const float qscale = 0.10206207261596577f * LOG2E;
    for (int idx = tid; idx < 384; idx += 256) {
        const int h = idx / 96, d = idx % 96; float v = qr[idx] * rq;
        if (d >= 64) { const int dd = d - 64, j = dd & 15; const float x1 = qr[h * 96 + 64 + j] * rq, x2 = qr[h * 96 + 80 + j] * rq, c = B.cosA[t * 16 + j], s = B.sinA[t * 16 + j]; v = dd < 16 ? x1 * c - x2 * s : x2 * c + x1 * s; }
        B.QM[(row * 4 + h) * 96 + d] = f2bf(v * qscale);
    }
    for (int idx = tid; idx < 512; idx += 256) {
        const int h = idx / 128, d = idx % 128; const float v = kr[idx] * rkv;
        if (d < 64) B.KM[(row * 4 + h) * 96 + d] = f2bf(v); else B.VM[(row * 4 + h) * 64 + d - 64] = f2bf(v);
    }
}

__global__ void __launch_bounds__(256) k_resid_post(const float* C, int b, Bufs B) {
    __shared__ float sh[4];
    const int t = blockIdx.x, tid = threadIdx.x; const size_t row = (size_t)b * S + t;
    f32x4 v = *(const f32x4*)(B.X + row * D + tid * 4); const f32x4 c = *(const f32x4*)(C + (size_t)t * D + tid * 4);
    v += c;
    *(f32x4*)(B.X + row * D + tid * 4) = v;
    bf16_t* xb = B.XB + row * D + tid * 4;
    xb[0] = f2bf(v[0]); xb[1] = f2bf(v[1]); xb[2] = f2bf(v[2]); xb[3] = f2bf(v[3]);
    const float ss = block_sum_256(v[0] * v[0] + v[1] * v[1] + v[2] * v[2] + v[3] * v[3], sh);
    if (tid == 0) B.RS[row] = rsqrtf(ss / (float)D + EPS);
}

__global__ void __launch_bounds__(256) k_conv_act(const float* U, bf16_t* ACT, const float* cw, const float* cb, int b, Bufs B) {
    const int t = blockIdx.y; const int c = blockIdx.x * 256 + threadIdx.x;
    if (c >= DFF) return;
    const size_t row = (size_t)b * S + t;
    float g = cb[c], u = cb[DFF + c];
#pragma unroll
    for (int j = 0; j < 3; ++j) { const int tt = t - 2 + j; if (tt >= 0) { const float rs = B.RS[row - 2 + j]; g += cw[j * NUP + c] * (U[(size_t)tt * NUP + c] * rs); u += cw[j * NUP + DFF + c] * (U[(size_t)tt * NUP + DFF + c] * rs); } }
    const float a = g / (1.f + __expf(-g)) * u;
    ACT[(size_t)t * DFF + c] = f2bf(a);
}

__global__ void __launch_bounds__(256) k_final(const float* g, Bufs B) {
    const size_t row = blockIdx.x; const int tid = threadIdx.x;
    const float rs = B.RS[row];
    f32x4 v = *(const f32x4*)(B.X + row * D + tid * 4); const f32x4 gg = *(const f32x4*)(g + tid * 4);
    v = v * rs * gg;
    *(f32x4*)(B.X + row * D + tid * 4) = v;
}

template <int DQK>
DI float dot_bf16(const float* q, const bf16_t* k) {
    float s = 0.f;
#pragma unroll
    for (int c = 0; c < DQK / 8; ++c) { const uint4 u = *(const uint4*)(k + c * 8); const unsigned w[4] = {u.x, u.y, u.z, u.w};
#pragma unroll
        for (int e = 0; e < 4; ++e) { s += q[c * 8 + 2 * e] * __uint_as_float(w[e] << 16); s += q[c * 8 + 2 * e + 1] * __uint_as_float(w[e] & 0xffff0000u); } }
    return s;
}
DI void acc_v64(float* o, float a, float p, const bf16_t* v) {
#pragma unroll
    for (int c = 0; c < 8; ++c) { const uint4 u = *(const uint4*)(v + c * 8); const unsigned w[4] = {u.x, u.y, u.z, u.w};
#pragma unroll
        for (int e = 0; e < 4; ++e) { o[c * 8 + 2 * e] = o[c * 8 + 2 * e] * a + p * __uint_as_float(w[e] << 16); o[c * 8 + 2 * e + 1] = o[c * 8 + 2 * e + 1] * a + p * __uint_as_float(w[e] & 0xffff0000u); } }
}
template <int DQK>
DI void load_q(float* q, const bf16_t* p) {
#pragma unroll
    for (int c = 0; c < DQK / 8; ++c) { const uint4 u = *(const uint4*)(p + c * 8); const unsigned w[4] = {u.x, u.y, u.z, u.w};
#pragma unroll
        for (int e = 0; e < 4; ++e) { q[c * 8 + 2 * e] = __uint_as_float(w[e] << 16); q[c * 8 + 2 * e + 1] = __uint_as_float(w[e] & 0xffff0000u); } }
}
DI void wave_merge_store(float m, float l, float* o, bf16_t* out, int lane) {
    const float mall = wave_max(m); const float f = exp2f(m - mall);
    l = wave_sum(l * f); const float inv = 1.f / l;
    float mine = 0.f;
#pragma unroll
    for (int d = 0; d < 64; ++d) { const float v = wave_sum(o[d] * f); if (lane == d) mine = v; }
    out[lane] = f2bf(mine * inv);
}

__global__ void __launch_bounds__(256) k_attn_mla_naive(Bufs B) {
    const int lane = threadIdx.x & 63; const size_t task = (size_t)blockIdx.x * 4 + (threadIdx.x >> 6);
    const size_t row = task >> 2; const int h = (int)(task & 3); const int b = (int)(row / S), t = (int)(row % S);
    float q[96]; load_q<96>(q, B.QM + (row * 4 + h) * 96);
    float m = -1e30f, l = 0.f, o[64];
#pragma unroll
    for (int d = 0; d < 64; ++d) o[d] = 0.f;
    for (int s = lane; s <= t; s += 64) {
        const size_t kr = (size_t)b * S + s;
        const float sc = dot_bf16<96>(q, B.KM + (kr * 4 + h) * 96);
        const float mn = fmaxf(m, sc), a = exp2f(m - mn), p = exp2f(sc - mn);
        l = l * a + p; acc_v64(o, a, p, B.VM + (kr * 4 + h) * 64); m = mn;
    }
    wave_merge_store(m, l, o, B.MIX + row * D + h * 64, lane);
}

__global__ void __launch_bounds__(256) k_attn_dil_naive(Bufs B) {
    const int lane = threadIdx.x & 63; const size_t task = (size_t)blockIdx.x * 4 + (threadIdx.x >> 6);
    const size_t row = task >> 3; const int h = (int)(task & 7); const int b = (int)(row / S), t = (int)(row % S);
    float q[64]; load_q<64>(q, B.DQ + (row * 8 + h) * 64);
    float m = -1e30f, l = 0.f, o[64];
#pragma unroll
    for (int d = 0; d < 64; ++d) o[d] = 0.f;
    for (int idx = lane; idx < 387; idx += 64) {
        const int p = idx / 129, j = idx % 129; const int dil = p == 0 ? 1 : (p == 1 ? 4 : 16);
        const int s = t - j * dil;
        if (s >= 0) {
            const size_t kr = (size_t)b * S + s;
            const float sc = dot_bf16<64>(q, B.DK + (kr * 8 + h) * 64);
            const float mn = fmaxf(m, sc), a = exp2f(m - mn), pp = exp2f(sc - mn);
            l = l * a + pp; acc_v64(o, a, pp, B.DV + (kr * 8 + h) * 64); m = mn;
        }
    }
    wave_merge_store(m, l, o, B.MIX + row * D + 256 + h * 64, lane);
}

DI unsigned sortable(float f) { const unsigned u = __float_as_uint(f); return (u & 0x80000000u) ? ~u : (u | 0x80000000u); }

__global__ void __launch_bounds__(256) k_dsa_naive(Bufs B) {
    __shared__ float sc[S];
    __shared__ float qi[256];
    __shared__ unsigned hist[256];
    __shared__ u64 s_prefix; __shared__ unsigned s_need, s_cnt;
    const int tid = threadIdx.x, lane = tid & 63, wid = tid >> 6;
    const size_t row = blockIdx.x; const int b = (int)(row / S), t = (int)(row % S), n = t + 1;
    __shared__ float wsh[8];
    qi[tid] = bf2f(B.QI[row * 256 + tid]);
    if (tid < 8) wsh[tid] = B.WI[row * 8 + tid];
    __syncthreads();
    for (int s = tid; s < n; s += 256) {
        float k[32]; load_q<32>(k, B.KI + ((size_t)b * S + s) * 32);
        float score = 0.f;
#pragma unroll 1
        for (int h = 0; h < 8; ++h) { float d = 0.f;
#pragma unroll
            for (int dd = 0; dd < 32; ++dd) d += qi[h * 32 + dd] * k[dd];
            score += wsh[h] * fmaxf(d, 0.f); }
        sc[s] = score;
    }
    __syncthreads();
    u64 thr = 0ull;
    if (n > 256) {
        if (tid == 0) { s_prefix = 0ull; s_need = 256u; s_cnt = 0u; }
        for (int p = 5; p >= 0; --p) {
            const int shift = 8 * p;
            hist[tid] = 0u;
            __syncthreads();
            const u64 pref = s_prefix;
            for (int s = tid; s < n; s += 256) { const u64 key = ((u64)sortable(sc[s]) << 13) | (u64)(8191 - s);
                if ((key >> (shift + 8)) == (pref >> (shift + 8))) atomicAdd(&hist[(unsigned)(key >> shift) & 255u], 1u); }
            __syncthreads();
            if (tid == 0) { unsigned need = s_need, cum = 0u; int dg = 255;
                for (; dg > 0; --dg) { const unsigned c = hist[dg]; if (cum + c >= need) break; cum += c; }
                s_prefix = pref | ((u64)dg << shift); s_need = need - cum; }
            __syncthreads();
        }
        thr = s_prefix;
    }
    const int h = wid;
    float q[64]; load_q<64>(q, B.SQ + (row * 4 + h) * 64);
    float m = -1e30f, l = 0.f, o[64];
#pragma unroll
    for (int d = 0; d < 64; ++d) o[d] = 0.f;
    for (int s = lane; s < n; s += 64) {
        const u64 key = ((u64)sortable(sc[s]) << 13) | (u64)(8191 - s);
        if (key >= thr) {
            const size_t kr = (size_t)b * S + s;
            const float s2 = dot_bf16<64>(q, B.SK + (kr * 4 + h) * 64);
            const float mn = fmaxf(m, s2), a = exp2f(m - mn), p = exp2f(s2 - mn);
            l = l * a + p; acc_v64(o, a, p, B.SV + (kr * 4 + h) * 64); m = mn;
        }
    }
    wave_merge_store(m, l, o, B.MIX + row * D + 768 + h * 64, lane);
}

extern "C" void kernel_launch(void* const* d_in, const int* in_sizes, int n_in, void* d_out, int out_size, void* d_ws, size_t ws_size, hipStream_t stream) {
    const float* x = (const float*)d_in[0];
    const float* g_attn = (const float*)d_in[1];
    const float* w_in = (const float*)d_in[2];
    const float* g_q_lat = (const float*)d_in[3];
    const float* w_uq = (const float*)d_in[4];
    const float* g_kv_lat = (const float*)d_in[5];
    const float* w_ukv = (const float*)d_in[6];
    const float* w_o = (const float*)d_in[7];
    const float* g_ffn = (const float*)d_in[8];
    const float* w_up = (const float*)d_in[9];
    const float* conv_w = (const float*)d_in[10];
    const float* conv_b = (const float*)d_in[11];
    const float* w_down = (const float*)d_in[12];
    const float* g_final = (const float*)d_in[13];
    Bufs B = make_bufs(d_out, d_ws);

    k_tables<<<S, 32, 0, stream>>>(B);
    k_prep_x<<<M, 256, 0, stream>>>(x, B);
    for (int l = 0; l < NL; ++l) {
        bf16_t* wl = B.W + (size_t)l * W_LAYER;
        bf16_t *WinT = wl, *WuqT = WinT + W_IN, *WukvT = WuqT + W_UQ, *WoT = WukvT + W_UKV, *WupT = WoT + W_O, *WdnT = WupT + W_UP;
        k_wconv<<<dim3(NINP / 32, D / 32), 256, 0, stream>>>(w_in + (size_t)l * D * NIN, g_attn + l * D, WinT, D, NIN, NINP, 0, 0);
        k_wconv<<<dim3(512 / 32, 256 / 32), 256, 0, stream>>>(w_uq + (size_t)l * 256 * 384, g_q_lat + l * 256, WuqT, 256, 384, 512, 1, 0);
        k_wconv<<<dim3(512 / 32, 128 / 32), 256, 0, stream>>>(w_ukv + (size_t)l * 128 * 512, g_kv_lat + l * 128, WukvT, 128, 512, 512, 2, 0);
        k_wconv<<<dim3(D / 32, D / 32), 256, 0, stream>>>(w_o + (size_t)l * D * D, nullptr, WoT, D, D, D, 3, 0);
        k_wconv<<<dim3(NUP / 32, D / 32), 256, 0, stream>>>(w_up + (size_t)l * D * NUP, g_ffn + l * D, WupT, D, NUP, NUP, 4, 0);
        k_wconv<<<dim3(D / 32, DFF / 32), 256, 0, stream>>>(w_down + (size_t)l * DFF * D, nullptr, WdnT, DFF, D, D, 5, 0);

        for (int b = 0; b < NB; ++b) {
            float* ZRAW = (float*)B.SCRA;
            k_gemm_naive<<<dim3(NINP / 128, S / 128), 256, 0, stream>>>(B.XB + (size_t)b * S * D, WinT, ZRAW, D, NINP);
            k_inproj_post<<<S, 256, 0, stream>>>(ZRAW, b, B);
        }
        for (int b = 0; b < NB; ++b) {
            float* QRAW = (float*)B.SCRA; float* KVRAW = QRAW + (size_t)S * 512;
            k_gemm_naive<<<dim3(512 / 128, S / 128), 256, 0, stream>>>(B.CQ + (size_t)b * S * 256, WuqT, QRAW, 256, 512);
            k_gemm_naive<<<dim3(512 / 128, S / 128), 256, 0, stream>>>(B.CKV + (size_t)b * S * 128, WukvT, KVRAW, 128, 512);
            k_mlaup_post<<<S, 256, 0, stream>>>(QRAW, KVRAW, b, B);
        }
        k_attn_mla_naive<<<M * 4 / 4, 256, 0, stream>>>(B);
        k_attn_dil_naive<<<M * 8 / 4, 256, 0, stream>>>(B);
        k_dsa_naive<<<M, 256, 0, stream>>>(B);
        for (int b = 0; b < NB; ++b) {
            float* C = (float*)B.Z;
            k_gemm_naive<<<dim3(D / 128, S / 128), 256, 0, stream>>>(B.MIX + (size_t)b * S * D, WoT, C, D, D);
            k_resid_post<<<S, 256, 0, stream>>>(C, b, B);
        }
        for (int b = 0; b < NB; ++b) {
            float* U = (float*)B.Z; bf16_t* ACT = (bf16_t*)(B.Z + (size_t)S * NUP * 4); float* C = (float*)B.SCRA;
            k_gemm_naive<<<dim3(NUP / 128, S / 128), 256, 0, stream>>>(B.XB + (size_t)b * S * D, WupT, U, D, NUP);
            k_conv_act<<<dim3(DFF / 256, S), 256, 0, stream>>>(U, ACT, conv_w + (size_t)l * 3 * NUP, conv_b + (size_t)l * NUP, b, B);
            k_gemm_naive<<<dim3(D / 128, S / 128), 256, 0, stream>>>(ACT, WdnT, C, DFF, D);
            k_resid_post<<<S, 256, 0, stream>>>(C, b, B);
        }
    }
    k_final<<<M, 256, 0, stream>>>(g_final, B);
}
```

```cpp
#include <hip/hip_runtime.h>
#include <stdint.h>

#define DI __device__ __forceinline__
#define LAS __attribute__((address_space(3)))
typedef unsigned short bf16_t;
typedef short bf16x8 __attribute__((ext_vector_type(8)));
typedef short s16x4 __attribute__((ext_vector_type(4)));
typedef float f32x4 __attribute__((ext_vector_type(4)));
typedef float f32x2 __attribute__((ext_vector_type(2)));
typedef float f32x16 __attribute__((ext_vector_type(16)));
typedef unsigned u32x4 __attribute__((ext_vector_type(4)));
typedef unsigned u32x2 __attribute__((ext_vector_type(2)));
typedef __bf16 bf16x2v __attribute__((ext_vector_type(2)));
typedef unsigned long long u64;

constexpr int NB = 4, S = 8192, D = 1024, NL = 4, M = NB * S;
constexpr int NIN = 3016, NINP = 3072, DFF = 2816, NUP = 2 * DFF, NLAT = 1024, KLAT = 384;
constexpr float EPS = 1e-6f;
constexpr float LOG2E = 1.4426950408889634f;
constexpr float THETA = 500000.0f;
constexpr float QSCALE_MLA = 0.10206207261596577f * LOG2E;
constexpr float QSCALE_64 = 0.125f * LOG2E;

DI bf16_t f2bf(float f) { unsigned u = __float_as_uint(f); u += 0x7fffu + ((u >> 16) & 1u); return (bf16_t)(u >> 16); }
DI float bf2f(bf16_t h) { return __uint_as_float(((unsigned)h) << 16); }
DI unsigned pk2(float lo, float hi) { f32x2 v = {lo, hi}; bf16x2v b = __builtin_convertvector(v, bf16x2v); return __builtin_bit_cast(unsigned, b); }
DI u32x4 pk8(f32x4 a, f32x4 b) { u32x4 w; w.x = pk2(a[0], a[1]); w.y = pk2(a[2], a[3]); w.z = pk2(b[0], b[1]); w.w = pk2(b[2], b[3]); return w; }
DI u32x2 pk4(f32x4 a) { u32x2 w; w.x = pk2(a[0], a[1]); w.y = pk2(a[2], a[3]); return w; }

constexpr size_t MiB = 1u << 20;
constexpr size_t OFF_CTL = 0;
constexpr size_t OFF_TAB = 1 * MiB;
constexpr size_t OFF_RS = 3 * MiB;
constexpr size_t OFF_W = 8 * MiB;
constexpr size_t OFF_XB = 110 * MiB;
constexpr size_t OFF_MIX = 174 * MiB;
constexpr size_t OFF_Z = 238 * MiB;
constexpr size_t CTL_BYTES = 1 * MiB;
constexpr size_t OFF_DUMP = 7 * MiB;

constexpr size_t W_IN = (size_t)NINP * D, W_LAT = (size_t)NLAT * KLAT, W_O = (size_t)D * D, W_UP = (size_t)NUP * D, W_DN = (size_t)D * DFF;
constexpr size_t W_LAYER = W_IN + W_LAT + W_O + W_UP + W_DN;
static_assert(OFF_W + W_LAYER * NL * 2 <= OFF_XB, "weights fit");

constexpr size_t ZQM = 0, ZVM = ZQM + (size_t)M * 768, ZCQKV = ZVM + (size_t)M * 512, ZKM = ZCQKV + (size_t)M * 768, ZDQ = ZKM + (size_t)M * 768,
                 ZDK = ZDQ + (size_t)M * 1024, ZDV = ZDK + (size_t)M * 1024, ZSQ = ZDV + (size_t)M * 1024, ZSK = ZSQ + (size_t)M * 512, ZSV = ZSK + (size_t)M * 512,
                 ZQI = ZSV + (size_t)M * 512, ZKI = ZQI + (size_t)M * 512, ZWI = ZKI + (size_t)M * 64, ZEND = ZWI + (size_t)M * 32;
static_assert(OFF_Z + ZEND <= 512 * MiB, "workspace map");
static_assert(OFF_Z + (size_t)M * DFF * 2 <= 512 * MiB, "ACT overlay");
constexpr size_t OFF_BND = OFF_Z + 180 * MiB;
static_assert(OFF_BND >= OFF_Z + (size_t)M * DFF * 2 && OFF_BND + (size_t)128 * 22 * 4 * 256 * 4 <= OFF_Z + ZEND, "conv boundary rows fit behind the ACT overlay");

struct Bufs {
    char* ws; float* Xp;
#define BUFP(T, name, off) DI T* name() const { return (T*)(ws + (off)); }
    DI float* X() const { return Xp; }
    BUFP(bf16_t, XB, OFF_XB)
    BUFP(float, RSP, OFF_RS)
    BUFP(float, RQP, OFF_RS + (size_t)M * 64)
    BUFP(float, RKVP, OFF_RS + (size_t)M * 96)
    BUFP(float, cosA, OFF_TAB) BUFP(float, sinA, OFF_TAB + S * 16 * 4) BUFP(float, cosH, OFF_TAB + S * 32 * 4) BUFP(float, sinH, OFF_TAB + S * 40 * 4)
    BUFP(float, cosI, OFF_TAB + S * 48 * 4) BUFP(float, sinI, OFF_TAB + S * 52 * 4)
    BUFP(bf16_t, W, OFF_W) BUFP(bf16_t, MIX, OFF_MIX)
    BUFP(bf16_t, QM, OFF_Z + ZQM) BUFP(bf16_t, VM, OFF_Z + ZVM) BUFP(bf16_t, CQKV, OFF_Z + ZCQKV) BUFP(bf16_t, KM, OFF_Z + ZKM)
    BUFP(bf16_t, DQ, OFF_Z + ZDQ) BUFP(bf16_t, DK, OFF_Z + ZDK) BUFP(bf16_t, DV, OFF_Z + ZDV)
    BUFP(bf16_t, SQ, OFF_Z + ZSQ) BUFP(bf16_t, SK, OFF_Z + ZSK) BUFP(bf16_t, SV, OFF_Z + ZSV)
    BUFP(bf16_t, QI, OFF_Z + ZQI) BUFP(bf16_t, KI, OFF_Z + ZKI) BUFP(float, WI, OFF_Z + ZWI)
    BUFP(bf16_t, ACT, OFF_Z)
    BUFP(char, Z, OFF_Z) BUFP(char, SCRA, OFF_MIX) BUFP(unsigned, CTL, OFF_CTL)
#undef BUFP
};
static Bufs make_bufs(void* d_out, void* d_ws) { Bufs B; B.ws = (char*)d_ws; B.Xp = (float*)d_out; return B; }

DI float shfl_xor_l(float v, int mask, int lane) { return __builtin_bit_cast(float, __builtin_amdgcn_ds_bpermute((lane ^ mask) << 2, __builtin_bit_cast(int, v))); }
DI int lane_id() { int l; asm volatile("v_mbcnt_lo_u32_b32 %0, -1, 0\n\tv_mbcnt_hi_u32_b32 %0, -1, %0" : "=v"(l)); return l; }
DI float wave_sum(float v) {
#pragma unroll
    for (int o = 32; o > 0; o >>= 1) v += __shfl_xor(v, o);
    return v;
}
DI float wave_sum_l(float v, int lane) {
#pragma unroll
    for (int o = 32; o > 0; o >>= 1) v += shfl_xor_l(v, o, lane);
    return v;
}
DI float wave_max(float v) {
#pragma unroll
    for (int o = 32; o > 0; o >>= 1) v = fmaxf(v, __shfl_xor(v, o));
    return v;
}
DI float block_sum_256(float v, float* sh) {
    v = wave_sum(v);
    __syncthreads();
    if ((threadIdx.x & 63) == 0) sh[threadIdx.x >> 6] = v;
    __syncthreads();
    return sh[0] + sh[1] + sh[2] + sh[3];
}
DI float rs_of(const float* RSP, size_t row) {
    const f32x4 a = *(const f32x4*)(RSP + row * 4);
    return rsqrtf(((a[0] + a[1]) + (a[2] + a[3])) * (1.f / (float)D) + EPS);
}
DI int src_in(int n, int perm) {
    if (n >= NIN) return -1;
    if (!perm) return n;
    const int g = n & ~31, ch = (n >> 2) & 7, e = n & 3;
    if (n >= 384 && n < 416) return g + 4 * ((ch >> 1) + 4 * (ch & 1)) + e;
    bool rh = false;
    if (n >= 416 && n < 416 + 1024) rh = (((n - 416) & 63) < 32);
    else if (n >= 1952 && n < 1952 + 512) rh = (((n - 1952) & 63) < 32);
    if (rh) { const int sc = (ch == 1) ? 2 : (ch == 2 ? 1 : ch); return g + 4 * sc + e; }
    return n;
}
#ifndef UP_PERM
#define UP_PERM 1
#endif
template <int DQK>
DI float dot_bf16(const float* q, const bf16_t* k) {
    float s = 0.f;
#pragma unroll
    for (int c = 0; c < DQK / 8; ++c) { const uint4 u = *(const uint4*)(k + c * 8); const unsigned w[4] = {u.x, u.y, u.z, u.w};
#pragma unroll
        for (int e = 0; e < 4; ++e) { s += q[c * 8 + 2 * e] * __uint_as_float(w[e] << 16); s += q[c * 8 + 2 * e + 1] * __uint_as_float(w[e] & 0xffff0000u); } }
    return s;
}
DI void acc_v64(float* o, float a, float p, const bf16_t* v) {
#pragma unroll
    for (int c = 0; c < 8; ++c) { const uint4 u = *(const uint4*)(v + c * 8); const unsigned w[4] = {u.x, u.y, u.z, u.w};
#pragma unroll
        for (int e = 0; e < 4; ++e) { o[c * 8 + 2 * e] = o[c * 8 + 2 * e] * a + p * __uint_as_float(w[e] << 16); o[c * 8 + 2 * e + 1] = o[c * 8 + 2 * e + 1] * a + p * __uint_as_float(w[e] & 0xffff0000u); } }
}
template <int DQK>
DI void load_q(float* q, const bf16_t* p) {
#pragma unroll
    for (int c = 0; c < DQK / 8; ++c) { const uint4 u = *(const uint4*)(p + c * 8); const unsigned w[4] = {u.x, u.y, u.z, u.w};
#pragma unroll
        for (int e = 0; e < 4; ++e) { q[c * 8 + 2 * e] = __uint_as_float(w[e] << 16); q[c * 8 + 2 * e + 1] = __uint_as_float(w[e] & 0xffff0000u); } }
}
DI unsigned sortable(float f) { const unsigned u = __float_as_uint(f); return (u & 0x80000000u) ? ~u : (u | 0x80000000u); }
namespace pg8 {
#define PG8_LAS __attribute__((address_space(3)))
typedef unsigned short bf16_t;
typedef short bf16x8 __attribute__((ext_vector_type(8)));
typedef float f32x4 __attribute__((ext_vector_type(4)));
typedef unsigned u32x4 __attribute__((ext_vector_type(4)));
constexpr int BM = 256, BK = 64, HALF = 128, HTB = HALF * BK * 2  , STAGE_BYTES = 8 * HTB, NXCD = 8, WGM = 8;

__host__ __device__ __forceinline__ int lds_byte(int r, int c) { const int st = (r >> 4) * 2 + (c >> 5), rr = r & 15, cc = c & 31, ob = rr * 64 + cc * 2; return st * 1024 + (ob ^ (((ob >> 9) & 1) << 5)); }
__host__ __device__ __forceinline__ void stage_rc(int b, int& R, int& C) { const int st = b / 1024, sb = b % 1024, swz = sb ^ (((sb >> 9) & 1) << 5); R = (st >> 1) * 16 + swz / 64; C = (st & 1) * 32 + (swz % 64) / 2; }
__host__ __device__ __forceinline__ int perm32(int rho) { const int n = rho >> 4, i = rho & 15; return 8 * (i >> 2) + 4 * n + (i & 3); }

struct Unit { int pm, pn; };
struct Gemm { const bf16_t* A; const bf16_t* Bt; int M, N, K; };

struct GridOrder {
    int nM, nN, nwg, G, c;
    __device__ void init(int nM_, int nN_, int G_, int c_) { nM = nM_; nN = nN_; nwg = nM * nN; G = G_; c = c_; }
    __device__ __forceinline__ bool next(int i, Unit& u) const {
        const long L = (long)i * G + c; if (L >= nwg) return false;
        int wgid = (int)L; { const int q = nwg / NXCD, r = nwg % NXCD, xcd = wgid % NXCD, off = wgid / NXCD; wgid = (xcd < r ? xcd * (q + 1) : r * (q + 1) + (xcd - r) * q) + off; }
        const int nig = WGM * nN, gid = wgid / nig, fm = gid * WGM, gsz = (nM - fm) < WGM ? (nM - fm) : WGM;
        u.pm = fm + ((wgid % nig) % gsz); u.pn = (wgid % nig) / gsz; return true;
    }
    __device__ __forceinline__ long arow(const Unit& u) const { return (long)u.pm * BM; }
    __device__ __forceinline__ void a_ready(const Unit&) const {}
    __device__ __forceinline__ void done(const Unit&) const {}
};
struct ConvOrder : GridOrder {
    __device__ __forceinline__ long arow(const Unit& u) const { const int b = u.pm / 33, j = u.pm % 33; return (long)b * 8192 + 254 * j - 2; }
};
template <class Epi, class Sched, bool ALIGN_EPI = false, bool SP2 = false>
__device__ __forceinline__ void gemm_phase(PG8_LAS unsigned char* lds, const Gemm g, const Sched& S, const Epi& E, const int wid) {
    int lane_ = lane_id(); asm volatile("" : "+v"(lane_));
    int wid_ = wid; asm volatile("" : "+s"(wid_));
    const int lane = lane_, tid = wid_ * 64 + lane, wr = wid_ >> 2, wc = wid_ & 3, fr = lane & 15, fq = lane >> 4;
    const int K = g.K, nt = K / BK;
    unsigned voffA[2], voffB[2];
#pragma unroll
    for (int i = 0; i < 2; ++i) { int R, C; stage_rc(tid * 16 + i * 8192, R, C); const int Rb = Epi::PERM ? ((R & ~31) + perm32(R & 31)) : R;
        voffA[i] = (unsigned)(R * K + C) * 2u; voffB[i] = (unsigned)(Rb * K + C) * 2u; }
    const size_t kstep = (size_t)(BK * 2);
    const size_t hstep = (size_t)HALF * K * 2;
    const size_t tstep = 2 * hstep;
    const unsigned ldsw = (unsigned)wid_ * 1024u;
    const int aoff = lds_byte(wr * 64 + fr, fq * 8), boff = lds_byte(wc * 32 + fr, fq * 8);
#define PG8_SA(b, h) (((b) * 2 + (h)) * HTB)
#define PG8_SB(b, h) ((4 + (b) * 2 + (h)) * HTB)
#define PG8_STAGE(bufoff, gbase, voff) do { _Pragma("unroll") for (int _i = 0; _i < 2; ++_i) \
        __builtin_amdgcn_global_load_lds((const unsigned*)((const char*)(gbase) + (voff)[_i]), (PG8_LAS unsigned*)(lds + (bufoff) + ldsw + _i * 8192), 16, 0, 0); } while (0)
#define PG8_LDA(dst, b, h) do { _Pragma("unroll") for (int m = 0; m < 4; ++m) _Pragma("unroll") for (int k = 0; k < 2; ++k) dst[m][k] = *(const PG8_LAS bf16x8*)(lds + PG8_SA(b, h) + aoff + m * 2048 + k * 1024); } while (0)
#define PG8_LDB(dst, b, h) do { _Pragma("unroll") for (int n = 0; n < 2; ++n) _Pragma("unroll") for (int k = 0; k < 2; ++k) dst[n][k] = *(const PG8_LAS bf16x8*)(lds + PG8_SB(b, h) + boff + n * 2048 + k * 1024); } while (0)
#define PG8_MMA(ai, bj, At, Bt) do { __builtin_amdgcn_s_setprio(1); _Pragma("unroll") for (int m = 0; m < 4; ++m) _Pragma("unroll") for (int n = 0; n < 2; ++n) _Pragma("unroll") for (int k = 0; k < 2; ++k) \
        acc[ai][bj][m][n] = __builtin_amdgcn_mfma_f32_16x16x32_bf16(Bt[n][k], At[m][k], acc[ai][bj][m][n], 0, 0, 0); __builtin_amdgcn_s_setprio(0); } while (0)
#define PG8_WAIT_V(n) asm volatile("s_waitcnt vmcnt(" #n ")" ::: "memory")
#define PG8_WAIT_L(n) asm volatile("s_waitcnt lgkmcnt(" #n ")" ::: "memory")
#define PG8_BAR __builtin_amdgcn_s_barrier()
#define PG8_SCHED __builtin_amdgcn_sched_barrier(0)
    Unit cur, nxt; int ui = 0;
    if (!S.next(0, cur)) return;
    f32x4 acc[2][2][4][2];
#pragma unroll
    for (int a = 0; a < 2; ++a)
#pragma unroll
        for (int b = 0; b < 2; ++b)
#pragma unroll
            for (int m = 0; m < 4; ++m)
#pragma unroll
                for (int n = 0; n < 2; ++n) acc[a][b][m][n] = (f32x4){0.f, 0.f, 0.f, 0.f};
    bf16x8 At[4][2], B0[2][2], B1[2][2];
    const char* cA = (const char*)g.A + S.arow(cur) * (long)(K * 2); const char* cB = (const char*)g.Bt + (size_t)cur.pn * tstep;
    S.a_ready(cur);
    if constexpr (SP2) {
        PG8_STAGE(PG8_SB(0, 0), cB, voffB); PG8_STAGE(PG8_SB(0, 1), cB + hstep, voffB); PG8_STAGE(PG8_SA(0, 0), cA, voffA); PG8_STAGE(PG8_SA(0, 1), cA + hstep, voffA);
        if (wr == 1) PG8_BAR;
        PG8_WAIT_V(2); PG8_BAR;
        PG8_STAGE(PG8_SB(1, 0), cB + kstep, voffB); PG8_STAGE(PG8_SA(1, 0), cA + kstep, voffA); PG8_STAGE(PG8_SB(1, 1), cB + hstep + kstep, voffB);
        PG8_WAIT_V(6); PG8_BAR;
    } else {
        PG8_STAGE(PG8_SB(0, 0), cB, voffB); PG8_STAGE(PG8_SA(0, 0), cA, voffA); PG8_STAGE(PG8_SB(0, 1), cB + hstep, voffB); PG8_STAGE(PG8_SA(0, 1), cA + hstep, voffA);
        if (wr == 1) PG8_BAR;
        PG8_WAIT_V(4); PG8_BAR;
        PG8_STAGE(PG8_SB(1, 0), cB + kstep, voffB); PG8_STAGE(PG8_SA(1, 0), cA + kstep, voffA); PG8_STAGE(PG8_SB(1, 1), cB + hstep + kstep, voffB);
        PG8_WAIT_V(6); PG8_BAR;
    }
    for (;;) {
        const bool has_next = S.next(ui + 1, nxt);
        const char* nA = has_next ? (const char*)g.A + S.arow(nxt) * (long)(K * 2) : cA; const char* nB = has_next ? (const char*)g.Bt + (size_t)nxt.pn * tstep : cB;
        for (int t = 0; t < nt; t += 2) {
            const bool last = (t == nt - 2);
            const char* a1 = cA + (size_t)(t + 1) * kstep;
            const char* a2 = last ? nA : cA + (size_t)(t + 2) * kstep; const char* b2 = last ? nB : cB + (size_t)(t + 2) * kstep;
            const char* a3 = a2 + kstep; const char* b3 = b2 + kstep;
            if (last && has_next) S.a_ready(nxt);
            if constexpr (SP2) {
            PG8_LDB(B0, 0, 0); PG8_LDB(B1, 0, 1); PG8_SCHED; PG8_LDA(At, 0, 0); PG8_STAGE(PG8_SA(1, 1), a1 + hstep, voffA);
            PG8_WAIT_V(8); PG8_WAIT_L(0); PG8_BAR; PG8_MMA(0, 0, At, B0); PG8_MMA(0, 1, At, B1); PG8_BAR; PG8_SCHED;
            PG8_LDA(At, 0, 1); PG8_STAGE(PG8_SB(0, 0), b2, voffB); PG8_STAGE(PG8_SB(0, 1), b2 + hstep, voffB); PG8_STAGE(PG8_SA(0, 0), a2, voffA);
            PG8_WAIT_V(8); PG8_WAIT_L(0); PG8_BAR; PG8_MMA(1, 0, At, B0); PG8_MMA(1, 1, At, B1); PG8_BAR; PG8_SCHED;
            PG8_LDB(B0, 1, 0); PG8_LDB(B1, 1, 1); PG8_SCHED; PG8_LDA(At, 1, 0); PG8_STAGE(PG8_SA(0, 1), a2 + hstep, voffA);
            PG8_WAIT_V(8); PG8_WAIT_L(0); PG8_BAR; PG8_MMA(0, 0, At, B0); PG8_MMA(0, 1, At, B1); PG8_BAR; PG8_SCHED;
            PG8_LDA(At, 1, 1); PG8_STAGE(PG8_SB(1, 0), b3, voffB); PG8_STAGE(PG8_SB(1, 1), b3 + hstep, voffB); PG8_STAGE(PG8_SA(1, 0), a3, voffA);
            PG8_WAIT_V(8); PG8_WAIT_L(0); PG8_BAR; PG8_MMA(1, 0, At, B0); PG8_MMA(1, 1, At, B1); PG8_BAR; PG8_SCHED;
            } else {
            PG8_LDB(B0, 0, 0); PG8_SCHED; PG8_LDA(At, 0, 0); PG8_STAGE(PG8_SA(1, 1), a1 + hstep, voffA);
            PG8_WAIT_L(8); PG8_BAR; PG8_WAIT_L(0); PG8_MMA(0, 0, At, B0); PG8_BAR; PG8_SCHED;
            PG8_LDB(B1, 0, 1); PG8_STAGE(PG8_SB(0, 0), b2, voffB);
            PG8_BAR; PG8_WAIT_L(0); PG8_MMA(0, 1, At, B1); PG8_BAR;
            PG8_LDA(At, 0, 1); PG8_STAGE(PG8_SA(0, 0), a2, voffA);
            PG8_BAR; PG8_WAIT_L(0); PG8_MMA(1, 0, At, B0); PG8_BAR; PG8_SCHED;
            PG8_STAGE(PG8_SB(0, 1), b2 + hstep, voffB);
            PG8_WAIT_V(6); PG8_BAR; PG8_MMA(1, 1, At, B1); PG8_BAR;
            PG8_LDB(B0, 1, 0); PG8_SCHED; PG8_LDA(At, 1, 0); PG8_STAGE(PG8_SA(0, 1), a2 + hstep, voffA);
            PG8_WAIT_L(8); PG8_BAR; PG8_WAIT_L(0); PG8_MMA(0, 0, At, B0); PG8_BAR; PG8_SCHED;
            PG8_LDB(B1, 1, 1); PG8_STAGE(PG8_SB(1, 0), b3, voffB);
            PG8_BAR; PG8_WAIT_L(0); PG8_MMA(0, 1, At, B1); PG8_BAR;
            PG8_LDA(At, 1, 1); PG8_STAGE(PG8_SA(1, 0), a3, voffA);
            PG8_BAR; PG8_WAIT_L(0); PG8_MMA(1, 0, At, B0); PG8_BAR; PG8_SCHED;
            PG8_STAGE(PG8_SB(1, 1), b3 + hstep, voffB);
            PG8_WAIT_V(6); PG8_BAR; PG8_MMA(1, 1, At, B1); PG8_BAR;
            }
        }
        if constexpr (ALIGN_EPI) { if (wr == 0) PG8_BAR; }
        if constexpr (!Epi::AFTER_DRAIN) { E(acc, cur, wr, wc, fr, fq); S.done(cur); }
        if (!has_next) break;
#pragma unroll
        for (int a = 0; a < 2; ++a)
#pragma unroll
            for (int b = 0; b < 2; ++b)
#pragma unroll
                for (int m = 0; m < 4; ++m)
#pragma unroll
                    for (int n = 0; n < 2; ++n) acc[a][b][m][n] = (f32x4){0.f, 0.f, 0.f, 0.f};
        cur = nxt; cA = nA; cB = nB; ++ui;
        if constexpr (ALIGN_EPI) { if (wr == 1) PG8_BAR; }
    }
    PG8_WAIT_V(0);
    if constexpr (!ALIGN_EPI) { if (wr == 0) PG8_BAR; }
    PG8_BAR;
    if constexpr (Epi::AFTER_DRAIN) { E.fused(acc, cur, wr, wc, fr, fq, lds, wid, lane); S.done(cur); }
#undef PG8_SA
#undef PG8_SB
#undef PG8_STAGE
#undef PG8_LDA
#undef PG8_LDB
#undef PG8_MMA
#undef PG8_WAIT_V
#undef PG8_WAIT_L
#undef PG8_BAR
#undef PG8_SCHED
}
}
using pg8::Unit;

DI void rope4(const f32x4 x1, const f32x4 x2, const float* cs, const float* sn, f32x4& o1, f32x4& o2) {
    const f32x4 c = *(const f32x4*)cs, s = *(const f32x4*)sn;
    o1 = x1 * c - x2 * s; o2 = x2 * c + x1 * s;
}

DI void rope4l(const f32x4 x1, const f32x4 x2, const LAS float* cs, const LAS float* sn, f32x4& o1, f32x4& o2) {
    const f32x4 c = *(const LAS f32x4*)cs, s = *(const LAS f32x4*)sn;
    o1 = x1 * c - x2 * s; o2 = x2 * c + x1 * s;
}
struct EpiInproj {
    static constexpr bool PERM = true, AFTER_DRAIN = false;
    Bufs B; LAS float* rb;
    DI void operator()(const f32x4 (&acc)[2][2][4][2], const Unit& u, int wr, int wc, int fr, int fq) const {
        { int l_ = lane_id(); asm volatile("" : "+v"(l_)); fr = l_ & 15; fq = l_ >> 4; }
        const int rowbase = u.pm * 256 + wr * 64 + fr;
        const bool hrope = u.pn * 256 + 256 > 416 && u.pn * 256 < 2464;
        if (hrope) {
            const int tid = (wr * 4 + wc) * 64 + fr + 16 * fq;
            if (tid < 256) { const int t = (u.pm * 256 + tid) & (S - 1);
                const f32x4 c0 = *(const f32x4*)(B.cosH() + t * 8), c1 = *(const f32x4*)(B.cosH() + t * 8 + 4), s0 = *(const f32x4*)(B.sinH() + t * 8), s1 = *(const f32x4*)(B.sinH() + t * 8 + 4);
                LAS f32x4* d = (LAS f32x4*)(rb + tid * 16); d[0] = c0; d[1] = c1; d[2] = s0; d[3] = s1; }
            asm volatile("s_waitcnt lgkmcnt(0)" ::: "memory");
            __builtin_amdgcn_s_barrier();
            asm volatile("" ::: "memory");
        }
        float rs[2][4];
#pragma unroll
        for (int ai = 0; ai < 2; ++ai)
#pragma unroll
            for (int m = 0; m < 4; ++m) rs[ai][m] = rs_of(B.RSP(), (size_t)(rowbase + ai * 128 + m * 16));
#pragma unroll
        for (int bj = 0; bj < 2; ++bj) {
            const int gcol = u.pn * 256 + bj * 128 + wc * 32;
            if (gcol >= 3040) continue;
#pragma unroll
            for (int ai = 0; ai < 2; ++ai)
#pragma unroll
                for (int m = 0; m < 4; ++m) {
                    const size_t row = (size_t)(rowbase + ai * 128 + m * 16); const int t = (int)(row & (S - 1));
                    const float r = rs[ai][m];
                    f32x4 v0 = acc[ai][bj][m][0] * r, v1 = acc[ai][bj][m][1] * r;
                    if (gcol < 384) {
                        *(u32x4*)(B.CQKV() + row * 384 + gcol + 8 * fq) = pk8(v0, v1);
                        float ss = (v0[0] * v0[0] + v0[1] * v0[1]) + (v0[2] * v0[2] + v0[3] * v0[3]) + (v1[0] * v1[0] + v1[1] * v1[1]) + (v1[2] * v1[2] + v1[3] * v1[3]);
                        ss += shfl_xor_l(ss, 16, fr + 16 * fq); ss += shfl_xor_l(ss, 32, fr + 16 * fq);
                        if (fq == 0) { if (gcol < 256) B.RQP()[row * 8 + (gcol >> 5)] = ss; else B.RKVP()[row * 4 + ((gcol - 256) >> 5)] = ss; }
                    } else if (gcol == 384) {
                        f32x4 o1, o2; rope4(v0, v1, B.cosA() + t * 16 + 4 * fq, B.sinA() + t * 16 + 4 * fq, o1, o2);
                        const u32x2 p1 = pk4(o1), p2 = pk4(o2);
#pragma unroll
                        for (int h = 0; h < 4; ++h) { *(u32x2*)(B.KM() + (row * 4 + h) * 96 + 64 + 4 * fq) = p1; *(u32x2*)(B.KM() + (row * 4 + h) * 96 + 80 + 4 * fq) = p2; }
                    } else if (gcol < 2720) {
                        const bool dil = gcol < 1952; const int c = dil ? gcol - 416 : gcol - 1952; const int hw = dil ? 512 : 256;
                        const int which = c / hw, hd = (c % hw) >> 6, half = (c >> 5) & 1;
                        bf16_t* dst = dil ? (which == 0 ? B.DQ() : (which == 1 ? B.DK() : B.DV())) : (which == 0 ? B.SQ() : (which == 1 ? B.SK() : B.SV()));
                        bf16_t* p = dst + (row * (dil ? 8 : 4) + hd) * 64 + half * 32;
                        const float qs = which == 0 ? QSCALE_64 : 1.f;
                        if (which < 2 && half == 0 && fq < 2) {
                            const LAS float* rr = rb + (wr * 64 + fr + ai * 128 + m * 16) * 16 + 4 * fq;
                            f32x4 o1, o2; rope4l(v0, v1, rr, rr + 8, o1, o2);
                            *(u32x2*)(p + 4 * fq) = pk4(o1 * qs); *(u32x2*)(p + 8 + 4 * fq) = pk4(o2 * qs);
                        } else *(u32x4*)(p + 8 * fq) = pk8(v0 * qs, v1 * qs);
                    } else if (gcol < 3008) {
                        if (fq == 0) { f32x4 o1, o2; rope4(v0, v1, B.cosI() + t * 4, B.sinI() + t * 4, o1, o2); v0 = o1; v1 = o2; }
                        bf16_t* p = gcol < 2976 ? B.QI() + row * 256 + (gcol - 2720) : B.KI() + row * 32;
                        *(u32x4*)(p + 8 * fq) = pk8(v0, v1);
                    } else {
                        if (fq == 0) { *(f32x4*)(B.WI() + row * 8) = v0 * 0.03125f; *(f32x4*)(B.WI() + row * 8 + 4) = v1 * 0.03125f; }
                    }
                }
        }
    }
};

struct EpiLat {
    static constexpr bool PERM = true, AFTER_DRAIN = false;
    Bufs B; LAS float* rl;
    DI void operator()(const f32x4 (&acc)[2][2][4][2], const Unit& u, int wr, int wc, int fr, int fq) const {
        { int l_ = lane_id(); asm volatile("" : "+v"(l_)); fr = l_ & 15; fq = l_ >> 4; }
        const int rowbase = u.pm * 256 + wr * 64 + fr;
        { const int tid = (wr * 4 + wc) * 64 + fr + 16 * fq;
          if (tid < 256) { const size_t row = (size_t)u.pm * 256 + tid;
            const f32x4 a = *(const f32x4*)(B.RQP() + row * 8), b = *(const f32x4*)(B.RQP() + row * 8 + 4), c = *(const f32x4*)(B.RKVP() + row * 4);
            rl[2 * tid] = rsqrtf((((a[0] + a[1]) + (a[2] + a[3])) + ((b[0] + b[1]) + (b[2] + b[3]))) * (1.f / 256.f) + EPS) * QSCALE_MLA;
            rl[2 * tid + 1] = rsqrtf(((c[0] + c[1]) + (c[2] + c[3])) * (1.f / 128.f) + EPS); }
          asm volatile("s_waitcnt lgkmcnt(0)" ::: "memory");
          __builtin_amdgcn_s_barrier();
          asm volatile("" ::: "memory"); }
#pragma unroll
        for (int bj = 0; bj < 2; ++bj) {
            const int g32 = (u.pn * 256 + bj * 128 + wc * 32) >> 5;
            if (g32 >= 28) continue;
#pragma unroll
            for (int ai = 0; ai < 2; ++ai)
#pragma unroll
                for (int m = 0; m < 4; ++m) {
                    const size_t row = (size_t)(rowbase + ai * 128 + m * 16); const int t = (int)(row & (S - 1));
                    if (g32 < 12) {
                        const float r = rl[2 * (wr * 64 + fr + ai * 128 + m * 16)];
                        const f32x4 v0 = acc[ai][bj][m][0] * r, v1 = acc[ai][bj][m][1] * r;
                        const int h = g32 / 3, part = g32 % 3; bf16_t* p = B.QM() + (row * 4 + h) * 96;
                        if (part < 2) *(u32x4*)(p + 32 * part + 8 * fq) = pk8(v0, v1);
                        else { f32x4 o1, o2; rope4(v0, v1, B.cosA() + t * 16 + 4 * fq, B.sinA() + t * 16 + 4 * fq, o1, o2); *(u32x2*)(p + 64 + 4 * fq) = pk4(o1); *(u32x2*)(p + 80 + 4 * fq) = pk4(o2); }
                    } else {
                        const float r = rl[2 * (wr * 64 + fr + ai * 128 + m * 16) + 1];
                        const f32x4 v0 = acc[ai][bj][m][0] * r, v1 = acc[ai][bj][m][1] * r;
                        const int gk = g32 - 12, h = gk >> 2, part = gk & 3;
                        if (part < 2) *(u32x4*)(B.KM() + (row * 4 + h) * 96 + 32 * part + 8 * fq) = pk8(v0, v1);
                        else *(u32x4*)(B.VM() + (row * 4 + h) * 64 + 32 * (part - 2) + 8 * fq) = pk8(v0, v1);
                    }
                }
        }
    }
};

template <bool DRY> struct EpiResidT {
    static constexpr bool PERM = true, AFTER_DRAIN = false;
    Bufs B; LAS float* red;
    DI void operator()(const f32x4 (&acc)[2][2][4][2], const Unit& u, int wr, int wc, int fr, int fq) const {
        { int l_ = lane_id(); asm volatile("" : "+v"(l_)); fr = l_ & 15; fq = l_ >> 4; }
        const int rowbase = u.pm * 256 + wr * 64 + fr;
#pragma unroll
        for (int ai = 0; ai < 2; ++ai)
#pragma unroll
            for (int m = 0; m < 4; ++m) {
                const size_t row = (size_t)(rowbase + ai * 128 + m * 16);
                float ss = 0.f;
#pragma unroll
                for (int bj = 0; bj < 2; ++bj) {
                    const int col0 = u.pn * 256 + bj * 128 + wc * 32 + 8 * fq;
                    float* xp = B.X() + row * D + col0;
                    f32x4 x0 = *(const f32x4*)xp, x1 = *(const f32x4*)(xp + 4);
                    x0 += acc[ai][bj][m][0]; x1 += acc[ai][bj][m][1];
                    if (DRY) { float* dp = (float*)(B.ws + OFF_DUMP) + (fr + 16 * fq) * 8; *(f32x4*)dp = x0; *(f32x4*)(dp + 4) = x1; *(u32x4*)(dp + 512) = pk8(x0, x1); }
                    else { *(f32x4*)xp = x0; *(f32x4*)(xp + 4) = x1;
                    *(u32x4*)(B.XB() + row * D + col0) = pk8(x0, x1); }
                    ss += ((x0[0] * x0[0] + x0[1] * x0[1]) + (x0[2] * x0[2] + x0[3] * x0[3])) + ((x1[0] * x1[0] + x1[1] * x1[1]) + (x1[2] * x1[2] + x1[3] * x1[3]));
                }
                ss += shfl_xor_l(ss, 16, fr + 16 * fq); ss += shfl_xor_l(ss, 32, fr + 16 * fq);
                if (fq == 0) red[wc * 256 + ai * 128 + wr * 64 + m * 16 + fr] = ss;
            }
        asm volatile("s_waitcnt lgkmcnt(0)" ::: "memory");
        __builtin_amdgcn_s_barrier();
        asm volatile("" ::: "memory");
        { const int wv = wr * 4 + wc, l = fr + 16 * fq;
          if (l < 32) { const int r = wv * 32 + l; const float t = (red[r] + red[256 + r]) + (red[512 + r] + red[768 + r]); if (DRY) ((float*)(B.ws + OFF_DUMP))[2048 + l] = t; else B.RSP()[((size_t)u.pm * 256 + r) * 4 + u.pn] = t; } }
    }
};
typedef EpiResidT<false> EpiResid;

#ifndef USE_DPP
#define USE_DPP 1
#endif
template <int N> DI float rot16(float v, int lane) {
#if USE_DPP
    return __builtin_bit_cast(float, __builtin_amdgcn_update_dpp(0, __builtin_bit_cast(int, v), 0x120 + N, 0xf, 0xf, false));
#else
    return __shfl(v, (lane & 48) | ((lane - N) & 15), 64);
#endif
}
template <int N> DI f32x4 rot16v(f32x4 v, int lane) { f32x4 r; r[0] = rot16<N>(v[0], lane); r[1] = rot16<N>(v[1], lane); r[2] = rot16<N>(v[2], lane); r[3] = rot16<N>(v[3], lane); return r; }
DI f32x4 sel4(bool c, f32x4 a, f32x4 b) { f32x4 r; r[0] = c ? a[0] : b[0]; r[1] = c ? a[1] : b[1]; r[2] = c ? a[2] : b[2]; r[3] = c ? a[3] : b[3]; return r; }

struct EpiConvAct {
    static constexpr bool PERM = true, AFTER_DRAIN = false;
    Bufs B; const float* cw; const float* cb; LAS float* halo;
    DI void operator()(const f32x4 (&acc_)[2][2][4][2], const Unit& u, int wr, int wc, int fr, int fq) const {
        { int l_ = lane_id(); asm volatile("" : "+v"(l_)); fr = l_ & 15; fq = l_ >> 4; }
        f32x4 (&us)[2][2][4][2] = const_cast<f32x4 (&)[2][2][4][2]>(acc_);
        const int lane = fr + 16 * fq;
        const int b = u.pm >> 5, j = u.pm & 31;
        const long arow = (long)u.pm * 256;
        LAS float* rsb = halo + 2048;
        LAS float* cwl = halo + 2048 + 256;
        { const int tid = (wr * 4 + wc) * 64 + lane; if (tid < 256) { rsb[tid] = rs_of(B.RSP(), (size_t)(arow + tid));
            const int bjc = tid >> 7, cc = tid & 127; const float* cwp = cw + bjc * DFF + u.pn * 128 + cc;
            cwl[0 * 256 + tid] = cwp[0]; cwl[1 * 256 + tid] = cwp[NUP]; cwl[2 * 256 + tid] = cwp[2 * NUP]; cwl[3 * 256 + tid] = cb[bjc * DFF + u.pn * 128 + cc]; } }
        asm volatile("s_waitcnt lgkmcnt(0)" ::: "memory");
        __builtin_amdgcn_s_barrier();
        asm volatile("" ::: "memory");
#pragma unroll
        for (int ai = 0; ai < 2; ++ai)
#pragma unroll
            for (int m = 0; m < 4; ++m) {
                const float r = rsb[ai * 128 + wr * 64 + m * 16 + fr];
#pragma unroll
                for (int bj = 0; bj < 2; ++bj) { us[ai][bj][m][0] = us[ai][bj][m][0] * r; us[ai][bj][m][1] = us[ai][bj][m][1] * r; }
            }
        { float* bnd = (float*)(B.ws + OFF_BND) + ((size_t)(u.pm * 22 + u.pn) * 4) * 256 + wc * 32 + 8 * fq;
          if (wr == 0 && fr < 2) {
#pragma unroll
              for (int bj = 0; bj < 2; ++bj)
#pragma unroll
                  for (int n = 0; n < 2; ++n) *(f32x4*)(bnd + fr * 256 + bj * 128 + 4 * n) = us[0][bj][0][n]; }
          if (wr == 1 && fr >= 14) {
#pragma unroll
              for (int bj = 0; bj < 2; ++bj)
#pragma unroll
                  for (int n = 0; n < 2; ++n) *(f32x4*)(bnd + (fr - 12) * 256 + bj * 128 + 4 * n) = us[1][bj][3][n]; } }
        if (fr >= 14) {
#pragma unroll
            for (int ai = 0; ai < 2; ++ai)
#pragma unroll
                for (int bj = 0; bj < 2; ++bj)
#pragma unroll
                    for (int n = 0; n < 2; ++n) {
                        const int g = 2 * ai + wr;
                        *(LAS f32x4*)(halo + ((((((g * 2 + bj) * 4 + wc) * 2 + (fr - 14)) * 4 + fq) * 2 + n) * 4)) = us[ai][bj][3][n];
                    }
        }
        asm volatile("s_waitcnt lgkmcnt(0)" ::: "memory");
        __builtin_amdgcn_s_barrier();
        asm volatile("" ::: "memory");
        float chain = 0.f;
#pragma unroll
        for (int n = 0; n < 2; ++n) {
#pragma unroll
            for (int bj = 0; bj < 2; ++bj) {
#pragma unroll
                for (int ai = 0; ai < 2; ++ai) {
                    int fro = fr, fqo = fq;
                    asm volatile("" : "+v"(fro), "+v"(fqo), "+v"(chain) :: "memory");
                    const int col = u.pn * 128 + wc * 32 + 8 * fqo + 4 * n;
                    const LAS float* cwq = cwl + bj * 128 + wc * 32 + 8 * fqo + 4 * n;
                    const f32x4 w0 = *(const LAS f32x4*)(cwq), w1 = *(const LAS f32x4*)(cwq + 256), w2 = *(const LAS f32x4*)(cwq + 512), bb = *(const LAS f32x4*)(cwq + 768);
                    const int g = 2 * ai + wr, gp = g > 0 ? g - 1 : 0;
                    const int hoff = (((((gp * 2 + bj) * 4 + wc) * 2 + 0) * 4 + fqo) * 2 + n) * 4;
                    const f32x4 h62 = *(const LAS f32x4*)(halo + hoff);
                    const f32x4 h63 = *(const LAS f32x4*)(halo + hoff + 32);
                    f32x4 r1p = h63, r2p = sel4(fro == 0, h62, h63);
                    const int lr0 = ai * 128 + wr * 64 + fro; const int t0 = 256 * j + lr0;
                    bf16_t* const orow = B.ACT() + ((size_t)b * S + t0) * DFF + col;
#pragma unroll
                    for (int m = 0; m < 4; ++m) {
                        const int lr = lr0 + m * 16, t = t0 + m * 16;
                        f32x4 cur;
                        { float c0 = us[ai][bj][m][n][0], c1 = us[ai][bj][m][n][1], c2 = us[ai][bj][m][n][2], c3 = us[ai][bj][m][n][3];
                          asm volatile("" : "+v"(c0), "+v"(c1), "+v"(c2), "+v"(c3), "+v"(chain) :: "memory");
                          cur[0] = c0; cur[1] = c1; cur[2] = c2; cur[3] = c3; }
                        const f32x4 r1 = rot16v<1>(cur, lane), r2 = rot16v<2>(cur, lane);
                        f32x4 p1 = sel4(fro >= 1, r1, r1p), p2 = sel4(fro >= 2, r2, r2p);
                        r1p = r1; r2p = r2;
                        const f32x4 y = bb + w2 * cur + w1 * p1 + w0 * p2;
                        chain = y[3];
                        if (bj == 0) {
                            f32x4 a;
#pragma unroll
                            for (int e = 0; e < 4; ++e) a[e] = y[e] * __builtin_amdgcn_rcpf(1.f + __builtin_amdgcn_exp2f(-LOG2E * y[e]));
                            us[ai][0][m][n] = a;
                        } else {
                            bf16_t* dst = lr >= 2 ? orow + (size_t)m * 16 * DFF : (bf16_t*)(B.ws + OFF_DUMP) + lane * 4;
                            *(u32x2*)dst = pk4(us[ai][0][m][n] * y);
                        }
                    }
                }
            }
        }
    }
};

DI void conv_fixup(const Bufs& B, const float* cw, const float* cb, int pm, int tid) {
    const float* bnd = (const float*)(B.ws + OFF_BND);
    const bool top = (pm & 31) == 0;
    constexpr int NQ = 6;
    { const int c0 = tid;
        float og[NQ][4], ou[NQ][4], wg[NQ][3], wu[NQ][3], bg[NQ], bu[NQ];
#pragma unroll
        for (int q = 0; q < NQ; ++q) { const int cq = c0 + 512 * q; const int c = cq < DFF ? cq : tid; const int pn = c >> 7, cc = c & 127;
            const float* own = bnd + ((size_t)(pm * 22 + pn) * 4) * 256 + cc; const float* prv = top ? own : own - (size_t)22 * 4 * 256;
            og[q][0] = prv[2 * 256]; og[q][1] = prv[3 * 256]; og[q][2] = own[0]; og[q][3] = own[256];
            ou[q][0] = prv[2 * 256 + 128]; ou[q][1] = prv[3 * 256 + 128]; ou[q][2] = own[128]; ou[q][3] = own[256 + 128];
#pragma unroll
            for (int k = 0; k < 3; ++k) { wg[q][k] = cw[k * NUP + c]; wu[q][k] = cw[k * NUP + DFF + c]; }
            bg[q] = cb[c]; bu[q] = cb[DFF + c]; }
#pragma unroll
        for (int q = 0; q < NQ; ++q) { const int cq = c0 + 512 * q; if (cq < DFF) {
            if (top) { og[q][0] = 0.f; og[q][1] = 0.f; ou[q][0] = 0.f; ou[q][1] = 0.f; }
#pragma unroll
            for (int r = 0; r < 2; ++r) {
                const float yg = bg[q] + wg[q][2] * og[q][r + 2] + wg[q][1] * og[q][r + 1] + wg[q][0] * og[q][r];
                const float yu = bu[q] + wu[q][2] * ou[q][r + 2] + wu[q][1] * ou[q][r + 1] + wu[q][0] * ou[q][r];
                const float a = yg * __builtin_amdgcn_rcpf(1.f + __builtin_amdgcn_exp2f(-LOG2E * yg));
                B.ACT()[((size_t)pm * 256 + r) * DFF + cq] = f2bf(a * yu); } } }
    }
}
#define XB_TMO      128
#define XB_XCNT(j)  (256  + 64 * (j))
#define XB_XSUB(j)  (1280 + 64 * (j))
#define XB_XGEN(j)  (2304 + 64 * (j))
#define XB_TOP      3328
#define XB_TOPGEN   3392
#define XCD_BAR_WORDS 3456
#define XB_SPIN_CAP (1u << 24)

__device__ __forceinline__ unsigned xb_ld(unsigned* p)              { return __hip_atomic_load(p, __ATOMIC_RELAXED, __HIP_MEMORY_SCOPE_AGENT); }
__device__ __forceinline__ unsigned xb_add(unsigned* p, unsigned v) { return __hip_atomic_fetch_add(p, v, __ATOMIC_RELAXED, __HIP_MEMORY_SCOPE_AGENT); }
__device__ __forceinline__ unsigned xb_xcc_id() { return (unsigned)__builtin_amdgcn_s_getreg((3 << 11) | 20) & 0xFu; }
#define XB_SPIN(cond, bar) do { unsigned _sp = 0; while (cond) { __builtin_amdgcn_s_sleep(1); \
    if ((++_sp & 255u) == 0u) { if (xb_ld(&(bar)[XB_TMO])) break; if (_sp > XB_SPIN_CAP) { atomicAdd(&(bar)[XB_TMO], 1u); break; } } } } while (0)

struct XcdBarrier { unsigned* bar; unsigned x; volatile LAS unsigned* st; };

__device__ __forceinline__ XcdBarrier xcd_barrier_post(unsigned* bar, volatile LAS unsigned* st, bool is_t0) {
    XcdBarrier b; b.bar = bar; b.x = xb_xcc_id(); b.st = st;
    if (is_t0) (void)xb_add(&bar[XB_XCNT(b.x)], 1u);
    return b;
}
__device__ __forceinline__ void xcd_barrier_complete(unsigned* bar, unsigned x, unsigned& nloc, unsigned& nx) {
    const unsigned G = gridDim.x * gridDim.y * gridDim.z;
    unsigned sum, cnt, mine, sp = 0u;
    for (;;) {
        sum = 0u; cnt = 0u; mine = 0u;
#pragma unroll
        for (unsigned j = 0; j < 16; ++j) { const unsigned c = xb_ld(&bar[XB_XCNT(j)]); sum += c; cnt += (c > 0u) ? 1u : 0u; mine = (j == x) ? c : mine; }
        if (sum == G) break;
        __builtin_amdgcn_s_sleep(1);
        if ((++sp & 255u) == 0u) { if (xb_ld(&bar[XB_TMO])) break; if (sp > XB_SPIN_CAP) { atomicAdd(&bar[XB_TMO], 1u); break; } }
    }
    nloc = mine > 0u ? mine : 1u; nx = cnt > 0u ? cnt : 1u;
}
__device__ __forceinline__ void xcd_barrier(const XcdBarrier& b, bool is_t0) {
    asm volatile("s_waitcnt vmcnt(0)" ::: "memory");
    __syncthreads();
    if (is_t0) {
        unsigned* bar = b.bar;
        __builtin_amdgcn_s_waitcnt(0);
        unsigned nloc = b.st[0], nx = b.st[1];
        if (nloc == 0u) { xcd_barrier_complete(bar, b.x, nloc, nx); b.st[0] = nloc; b.st[1] = nx; }
        const unsigned old = xb_add(&bar[XB_XSUB(b.x)], 1u);
        const unsigned gen = old / nloc;
        if (old + 1u == (gen + 1u) * nloc) {
            __builtin_amdgcn_fence(__ATOMIC_RELEASE, "agent");
            asm volatile("s_waitcnt vmcnt(0)" ::: "memory");
            const unsigned og = xb_add(&bar[XB_TOP], 1u);
            const unsigned tg = og / nx;
            if (og + 1u == (tg + 1u) * nx) xb_add(&bar[XB_TOPGEN], 1u);
            else XB_SPIN(xb_ld(&bar[XB_TOPGEN]) == tg, bar);
            __builtin_amdgcn_fence(__ATOMIC_ACQUIRE, "agent");
            xb_add(&bar[XB_XGEN(b.x)], 1u);
            asm volatile("s_waitcnt vmcnt(0)" ::: "memory");
        } else {
            XB_SPIN(xb_ld(&bar[XB_XGEN(b.x)]) == gen, bar);
            __builtin_amdgcn_fence(__ATOMIC_ACQUIRE, "agent");
            asm volatile("s_waitcnt vmcnt(0)" ::: "memory");
        }
    }
    __syncthreads();
}

constexpr int NWAVES = 8, NTHR = NWAVES * 64;
constexpr int LDS_BYTES = 163840;
constexpr int LDS_STAGE = 0;
constexpr int LDS_HALO = 131072;
constexpr int LDS_MISC = LDS_BYTES - 64;

typedef short v4i16_t __attribute__((ext_vector_type(4)));
#define MFMA32(a, b, c) __builtin_amdgcn_mfma_f32_32x32x16_bf16((a), (b), (c), 0, 0, 0)
DI s16x4 vtr(const LAS char* p) { return __builtin_bit_cast(s16x4, __builtin_amdgcn_ds_read_tr16_b64_v4i16((LAS v4i16_t*)p)); }
DI int keyperm(int i) { return (i & 0x13) | ((i & 4) << 1) | ((i & 8) >> 1); }
constexpr int VT_STRIDE = 192, VT_BYTES = 32 * VT_STRIDE;
constexpr float NEG_BIG = -1e30f;

struct AttnState { f32x16 o0, o1; float m, l; };
DI void attn_init(AttnState& st) {
#pragma unroll
    for (int r = 0; r < 16; ++r) { st.o0[r] = 0.f; st.o1[r] = 0.f; }
    st.m = NEG_BIG; st.l = 0.f;
}
template <int NKS> struct KVTile { u32x4 kc[NKS]; u32x4 vc[4]; };
template <int NKS> DI int k_lds_off(int row, int chunk) { return NKS == 4 ? row * 128 + ((chunk ^ (row & 7)) << 4) : row * 208 + chunk * 16; }
template <int NKS> constexpr int k_lds_bytes() { return NKS == 4 ? 4096 : 6656; }
typedef __amdgpu_buffer_rsrc_t rsrc_t;
DI rsrc_t make_rsrc(const void* base) { return __builtin_amdgcn_make_buffer_rsrc((void*)base, 0, 0x7fffffff, 0x00020000); }
template <int NKS> DI void kv_load(KVTile<NKS>& T, rsrc_t kr, const unsigned (&ko)[NKS], int ksoff, rsrc_t vr, const unsigned (&vo)[4], int vsoff) {
#pragma unroll
    for (int j = 0; j < NKS; ++j) T.kc[j] = __builtin_amdgcn_raw_buffer_load_b128(kr, ko[j], ksoff, 0);
#pragma unroll
    for (int j = 0; j < 4; ++j) T.vc[j] = __builtin_amdgcn_raw_buffer_load_b128(vr, vo[j], vsoff, 0);
}
template <int NKS, class MaskF>
DI void attn_core(AttnState& st, const bf16x8 (&qf)[NKS], const LAS char* kl, const LAS char* vl, int rowbase, int lane, const MaskF& mask) {
    const int hi = lane >> 5, n = lane & 31;
    f32x16 sa;
#pragma unroll
    for (int r = 0; r < 16; ++r) { const int kk = 16 * (r >> 3) + 8 * hi + (r & 7); sa[r] = mask(n, kk, r) ? 0.f : -1e30f; }
    const int krow = rowbase + keyperm(n);
#pragma unroll
    for (int s = 0; s < NKS; ++s) { const bf16x8 kf = *(const LAS bf16x8*)(kl + k_lds_off<NKS>(krow, 2 * s + hi)); sa = MFMA32(kf, qf[s], sa); }
    float tmax;
    asm volatile("s_nop 7\n\ts_nop 7\n\ts_nop 1\n\tv_max3_f32 %0, %1, %2, %3" : "=v"(tmax) : "v"(sa[0]), "v"(sa[1]), "v"(-1e20f));
#pragma unroll
    for (int r = 2; r < 16; r += 2) asm("v_max3_f32 %0, %1, %2, %3" : "=v"(tmax) : "v"(tmax), "v"(sa[r]), "v"(sa[r + 1]));
    tmax = fmaxf(tmax, shfl_xor_l(tmax, 32, lane));
    const float mn = fmaxf(st.m, tmax);
    if (__builtin_amdgcn_ballot_w64(mn > st.m) != 0ull) {
        const float alpha = __builtin_amdgcn_exp2f(st.m - mn);
        st.l *= alpha; st.m = mn;
#pragma unroll
        for (int r = 0; r < 16; ++r) { st.o0[r] *= alpha; st.o1[r] *= alpha; }
    }
    float rsum = 0.f;
#pragma unroll
    for (int r = 0; r < 16; ++r) { const float p = __builtin_amdgcn_exp2f(sa[r] - mn); sa[r] = p; rsum += p; }
    st.l += rsum;
    bf16x8 pf[2];
#pragma unroll
    for (int s = 0; s < 2; ++s) { u32x4 w; w.x = pk2(sa[8 * s], sa[8 * s + 1]); w.y = pk2(sa[8 * s + 2], sa[8 * s + 3]); w.z = pk2(sa[8 * s + 4], sa[8 * s + 5]); w.w = pk2(sa[8 * s + 6], sa[8 * s + 7]); pf[s] = __builtin_bit_cast(bf16x8, w); }
    const int g = lane >> 4, i16 = lane & 15, q = i16 >> 2, p = i16 & 3;
    const LAS char* vr = vl + (rowbase + 8 * (g >> 1) + q) * VT_STRIDE + (16 * (g & 1) + 4 * p) * 2;
#pragma unroll
    for (int db = 0; db < 2; ++db)
#pragma unroll
        for (int s = 0; s < 2; ++s) {
            const s16x4 lo = vtr(vr + (16 * s) * VT_STRIDE + 64 * db), hi4 = vtr(vr + (16 * s + 4) * VT_STRIDE + 64 * db);
            const bf16x8 vf = __builtin_shufflevector(lo, hi4, 0, 1, 2, 3, 4, 5, 6, 7);
            if (db == 0) st.o0 = MFMA32(vf, pf[s], st.o0); else st.o1 = MFMA32(vf, pf[s], st.o1);
        }
}
constexpr float MASKED_S = -1e30f, M_FLOOR = -1e20f;
DI float max3f(float a, float b, float c) { float r; asm("v_max3_f32 %0, %1, %2, %3" : "=v"(r) : "v"(a), "v"(b), "v"(c)); return r; }
template <int NKS, bool ANYMASK, class MaskF>
DI void qk64(f32x16& sa, f32x16& sb, const bf16x8 (&qf)[NKS], const LAS char* kl, int lane, const MaskF& mask) {
    const int hi = lane >> 5, n = lane & 31;
#pragma unroll
    for (int r = 0; r < 16; ++r) {
        if (ANYMASK) { const int kk = 16 * (r >> 3) + 8 * hi + (r & 7); sa[r] = mask(0, n, kk, r) ? 0.f : MASKED_S; sb[r] = mask(1, n, kk, r) ? 0.f : MASKED_S; }
        else { sa[r] = 0.f; sb[r] = 0.f; }
    }
    const int krow = keyperm(n);
#pragma unroll
    for (int s = 0; s < NKS; ++s) {
        const bf16x8 ka = *(const LAS bf16x8*)(kl + k_lds_off<NKS>(krow, 2 * s + hi)), kb = *(const LAS bf16x8*)(kl + k_lds_off<NKS>(32 + krow, 2 * s + hi));
        sa = MFMA32(ka, qf[s], sa); sb = MFMA32(kb, qf[s], sb);
    }
}
DI void smpv64(AttnState& st, f32x16& sa, f32x16& sb, const LAS char* vl, int lane) {
    float tmax;
    asm volatile("s_nop 7\n\ts_nop 7\n\ts_nop 1\n\tv_max3_f32 %0, %1, %2, %3" : "=v"(tmax) : "v"(sa[0]), "v"(sb[0]), "v"(M_FLOOR));
#pragma unroll
    for (int r = 1; r < 16; ++r) tmax = max3f(tmax, sa[r], sb[r]);
    tmax = fmaxf(tmax, shfl_xor_l(tmax, 32, lane));
    const float mn = fmaxf(st.m, tmax);
    if (__builtin_amdgcn_ballot_w64(mn > st.m) != 0ull) {
        const float alpha = __builtin_amdgcn_exp2f(st.m - mn);
        st.l *= alpha; st.m = mn;
#pragma unroll
        for (int r = 0; r < 16; ++r) { st.o0[r] *= alpha; st.o1[r] *= alpha; }
    }
    float rsum = 0.f;
#pragma unroll
    for (int r = 0; r < 16; r += 2) {
        const f32x2 mm = {mn, mn}; const f32x2 ta = (f32x2){sa[r], sa[r + 1]} - mm, tb = (f32x2){sb[r], sb[r + 1]} - mm;
        const float pa0 = __builtin_amdgcn_exp2f(ta[0]), pa1 = __builtin_amdgcn_exp2f(ta[1]), pb0 = __builtin_amdgcn_exp2f(tb[0]), pb1 = __builtin_amdgcn_exp2f(tb[1]);
        sa[r] = pa0; sa[r + 1] = pa1; sb[r] = pb0; sb[r + 1] = pb1; rsum += (pa0 + pa1) + (pb0 + pb1); }
    st.l += rsum;
    bf16x8 pfa[2], pfb[2];
#pragma unroll
    for (int s = 0; s < 2; ++s) {
        u32x4 w; w.x = pk2(sa[8 * s], sa[8 * s + 1]); w.y = pk2(sa[8 * s + 2], sa[8 * s + 3]); w.z = pk2(sa[8 * s + 4], sa[8 * s + 5]); w.w = pk2(sa[8 * s + 6], sa[8 * s + 7]); pfa[s] = __builtin_bit_cast(bf16x8, w);
        u32x4 v; v.x = pk2(sb[8 * s], sb[8 * s + 1]); v.y = pk2(sb[8 * s + 2], sb[8 * s + 3]); v.z = pk2(sb[8 * s + 4], sb[8 * s + 5]); v.w = pk2(sb[8 * s + 6], sb[8 * s + 7]); pfb[s] = __builtin_bit_cast(bf16x8, v);
    }
    const int g = lane >> 4, i16 = lane & 15, q = i16 >> 2, p = i16 & 3;
    const LAS char* vr = vl + (8 * (g >> 1) + q) * VT_STRIDE + (16 * (g & 1) + 4 * p) * 2;
#pragma unroll
    for (int sub = 0; sub < 2; ++sub)
#pragma unroll
        for (int db = 0; db < 2; ++db)
#pragma unroll
            for (int s = 0; s < 2; ++s) {
                const s16x4 lo = vtr(vr + (32 * sub + 16 * s) * VT_STRIDE + 64 * db), hi4 = vtr(vr + (32 * sub + 16 * s + 4) * VT_STRIDE + 64 * db);
                const bf16x8 vf = __builtin_shufflevector(lo, hi4, 0, 1, 2, 3, 4, 5, 6, 7);
                const bf16x8 pf = sub == 0 ? pfa[s] : pfb[s];
                if (db == 0) st.o0 = MFMA32(vf, pf, st.o0); else st.o1 = MFMA32(vf, pf, st.o1);
            }
}
template <int NKS, bool ANYMASK, class MaskF>
DI void attn_core64(AttnState& st, const bf16x8 (&qf)[NKS], const LAS char* kl, const LAS char* vl, int lane, const MaskF& mask) {
    f32x16 sa, sb; qk64<NKS, ANYMASK>(sa, sb, qf, kl, lane, mask); smpv64(st, sa, sb, vl, lane);
}
struct Mask64None { DI bool operator()(int, int, int, int) const { return true; } };
struct Mask64Causal { int ta, tb, tw; DI bool operator()(int sub, int n, int kk, int) const { const int t = sub == 0 ? ta : tb; return t < tw || (t == tw && kk <= n); } };
struct Mask64Bits { unsigned ba, bb; DI bool operator()(int sub, int, int, int r) const { return ((sub == 0 ? ba : bb) >> r) & 1u; } };
template <int NKS, class MaskF>
DI void attn_tile(AttnState& st, const bf16x8 (&qf)[NKS], const KVTile<NKS>& T, LAS char* kl, LAS char* vl, int lane, const MaskF& mask) {
#pragma unroll
    for (int j = 0; j < NKS; ++j) { const int cid = lane + 64 * j; *(LAS u32x4*)(kl + k_lds_off<NKS>(cid / (2 * NKS), cid % (2 * NKS))) = T.kc[j]; }
#pragma unroll
    for (int j = 0; j < 4; ++j) { const int cid = lane + 64 * j; *(LAS u32x4*)(vl + (cid >> 3) * VT_STRIDE + (cid & 7) * 16) = T.vc[j]; }
    attn_core<NKS>(st, qf, kl, vl, 0, lane, mask);
}
DI void attn_store(const AttnState& st, bf16_t* orow  , int lane) {
    const int hi = lane >> 5;
    const float lt = st.l + shfl_xor_l(st.l, 32, lane); const float inv = 1.f / lt;
#pragma unroll
    for (int rg = 0; rg < 4; ++rg) {
        f32x4 a = {st.o0[4 * rg] * inv, st.o0[4 * rg + 1] * inv, st.o0[4 * rg + 2] * inv, st.o0[4 * rg + 3] * inv};
        f32x4 b = {st.o1[4 * rg] * inv, st.o1[4 * rg + 1] * inv, st.o1[4 * rg + 2] * inv, st.o1[4 * rg + 3] * inv};
        *(u32x2*)(orow + 8 * rg + 4 * hi) = pk4(a); *(u32x2*)(orow + 32 + 8 * rg + 4 * hi) = pk4(b);
    }
}

struct MaskBits { unsigned bits; DI bool operator()(int, int, int r) const { return (bits >> r) & 1u; } };
struct MaskNone { DI bool operator()(int, int, int) const { return true; } };
struct MaskCausal { DI bool operator()(int n, int kk, int) const { return kk <= n; } };
struct MaskWin { int d0, stride; unsigned lim; DI bool operator()(int, int, int r) const { return (unsigned)(d0 - stride * (16 * (r >> 3) + (r & 7))) <= lim; } };

#ifndef ATT_VARIANT
#define ATT_VARIANT 0
#endif
template <int NKS>
DI void attn_probe_core(AttnState& st, const bf16x8 (&qf)[NKS], const LAS char* kl, int lane, int variant) {
    if (variant < 2) return;
    const int hi = lane >> 5, n = lane & 31;
    f32x16 sa, sb;
#pragma unroll
    for (int r = 0; r < 16; ++r) { sa[r] = 0.f; sb[r] = 0.f; }
    const int krow = keyperm(n);
    bf16x8 ka[NKS], kb[NKS];
#pragma unroll
    for (int s = 0; s < NKS; ++s) { ka[s] = *(const LAS bf16x8*)(kl + k_lds_off<NKS>(krow, 2 * s + hi)); kb[s] = *(const LAS bf16x8*)(kl + k_lds_off<NKS>(32 + krow, 2 * s + hi)); }
    __builtin_amdgcn_sched_barrier(0);
#pragma unroll
    for (int s = 0; s < NKS; ++s) { sa = MFMA32(ka[s], qf[s], sa); sb = MFMA32(kb[s], qf[s], sb); }
    if (variant == 2) {
#pragma unroll
        for (int r = 0; r < 16; ++r) st.o0[r] += sa[r] + sb[r];
        return;
    }
    float tmax = NEG_BIG;
#pragma unroll
    for (int r = 0; r < 16; ++r) tmax = fmaxf(tmax, fmaxf(sa[r], sb[r]));
    tmax = fmaxf(tmax, shfl_xor_l(tmax, 32, lane));
    const float mn = fmaxf(st.m, tmax);
    if (__builtin_amdgcn_ballot_w64(mn > st.m) != 0ull) { const float alpha = __builtin_amdgcn_exp2f(st.m - mn); st.l *= alpha; st.m = mn;
#pragma unroll
        for (int r = 0; r < 16; ++r) { st.o0[r] *= alpha; st.o1[r] *= alpha; } }
    float rsum = 0.f; unsigned acc = 0u;
#pragma unroll
    for (int r = 0; r < 16; ++r) { const float pa = __builtin_amdgcn_exp2f(sa[r] - mn), pb = __builtin_amdgcn_exp2f(sb[r] - mn); rsum += pa + pb; acc ^= pk2(pa, pb); }
    st.l += rsum; st.o1[0] += __uint_as_float(acc & 0x3fffffffu);
}
constexpr size_t OFF_MASKG = (OFF_Z + ZEND + 255) & ~(size_t)255;
static_assert(OFF_MASKG + (size_t)NB * 32896 * 128 <= 512 * MiB, "mask words fit the workspace");
DI size_t maskg_word(int b, int qb, int tile) { return ((size_t)b * 32896 + (size_t)(qb * (qb + 1) / 2 + tile)) * 32; }
template <int NKS> constexpr int stage_bytes() { return (NKS == 4 ? 64 * 128 : 64 * 208) + 64 * VT_STRIDE; }
#define VMWAIT(n) asm volatile("s_waitcnt vmcnt(" #n ")" ::: "memory")
template <int NKS, bool MASKED, bool PIPE>
DI void attn_shared_unit(LAS unsigned char* lds, const bf16_t* qrowp  , const char* kg  , int krb,
                         const char* vg, int vrb, const unsigned* maskq  , bf16_t* orow, int Q, int wave, int lane, int variant) {
    constexpr int KIMG = NKS == 4 ? 64 * 128 : 64 * 208, STAGE = stage_bytes<NKS>();
    constexpr int NPK = KIMG / 1024, NPV = 64 * VT_STRIDE / 1024, NP = NPK + NPV, NPW = (NP + 7) / 8;
    constexpr int MSK_OFF = 4 * STAGE;
    const int hi = lane >> 5, n = lane & 31;
    bf16x8 qf[NKS];
#pragma unroll
    for (int s = 0; s < NKS; ++s) qf[s] = *(const bf16x8*)(qrowp + 16 * s + 8 * hi);
    AttnState st; attn_init(st);
    unsigned goff[NPW]; int loff[NPW]; bool isv[NPW];
#pragma unroll
    for (int k = 0; k < NPW; ++k) {
        int pc = wave + 8 * k; if (pc >= NP) pc -= NP;
        if (pc < NPK) { isv[k] = false; loff[k] = pc * 1024;
            if (NKS == 4) { const int row = 8 * pc + (lane >> 3), ch = (lane & 7) ^ ((lane >> 3) & 7); goff[k] = (unsigned)(row * krb + ch * 16); }
            else { const int sidx = 64 * pc + lane, row = sidx / 13, c = sidx % 13; goff[k] = (unsigned)(row * krb + (c < 12 ? c : 0) * 16); } }
        else { const int pv = pc - NPK; isv[k] = true; loff[k] = KIMG + pv * 1024; const int sidx = 64 * pv + lane, row = sidx / 12, c = sidx % 12; goff[k] = (unsigned)(row * vrb + (c < 8 ? c : 0) * 16); }
    }
    const int tw = 8 * Q + wave, nst = 4 * Q + 4;
    const unsigned* mq = maskq + n;
#define GLDS16(gp, ldsaddr) do { unsigned keep_; asm volatile("s_mov_b32 %0, m0\n\ts_mov_b32 m0, %2\n\ts_nop 0\n\tglobal_load_lds_dwordx4 %1, off\n\ts_mov_b32 m0, %0" : "=&s"(keep_) : "v"(gp), "s"(ldsaddr) : "memory"); } while (0)
#define GLDS4(gp, ldsaddr) do { unsigned keep_; asm volatile("s_mov_b32 %0, m0\n\ts_mov_b32 m0, %2\n\ts_nop 0\n\tglobal_load_lds_dword %1, off\n\ts_mov_b32 m0, %0" : "=&s"(keep_) : "v"(gp), "s"(ldsaddr) : "memory"); } while (0)
    const unsigned lds0 = (unsigned)(size_t)lds;
#define STG_DMA(jj) do { const int j_ = (jj); const unsigned sb_ = lds0 + (unsigned)((j_ & 3) * STAGE); \
        _Pragma("unroll") for (int k = 0; k < NPW; ++k) { const char* gp_ = (isv[k] ? vg + (size_t)j_ * 64 * vrb : kg + (size_t)j_ * 64 * krb) + goff[k]; \
            const unsigned la_ = (unsigned)__builtin_amdgcn_readfirstlane((int)(sb_ + (unsigned)loff[k])); GLDS16(gp_, la_); } \
        if (MASKED) { int t_ = 2 * j_ + hi; t_ = t_ <= tw ? t_ : tw; const unsigned* mp_ = mq + (size_t)t_ * 32; \
            const unsigned la_ = (unsigned)__builtin_amdgcn_readfirstlane((int)(lds0 + (unsigned)(MSK_OFF + wave * 1024 + (j_ & 3) * 256))); GLDS4(mp_, la_); } } while (0)
    constexpr int NL = NPW + (MASKED ? 1 : 0);
#define VMWAIT_NL(mult) do { if (NL * (mult) == 3) VMWAIT(3); else if (NL * (mult) == 4) VMWAIT(4); else if (NL * (mult) == 5) VMWAIT(5); else if (NL * (mult) == 6) VMWAIT(6); else if (NL * (mult) == 8) VMWAIT(8); else VMWAIT(10); } while (0)
#define STG_MASK(jj, ba, bb) unsigned ba = 0u, bb = 0u; if (MASKED) { const LAS unsigned* mw_ = (const LAS unsigned*)(lds + MSK_OFF + wave * 1024 + ((jj) & 3) * 256); \
        const unsigned m0_ = mw_[n], m1_ = mw_[32 + n]; ba = ((m0_ >> (8 * hi)) & 0xffu) | (((m0_ >> (16 + 8 * hi)) & 0xffu) << 8); \
        bb = 2 * (jj) + 1 <= tw ? ((m1_ >> (8 * hi)) & 0xffu) | (((m1_ >> (16 + 8 * hi)) & 0xffu) << 8) : 0u; }
    __builtin_amdgcn_s_waitcnt(0x0F70);
    asm volatile("s_barrier" ::: "memory");
    STG_DMA(0); STG_DMA(1); STG_DMA(2);
    VMWAIT_NL(2);
    asm volatile("s_barrier" ::: "memory");
    st.m = M_FLOOR;
    f32x16 sa, sb;
#define STG_QK(SA_, SB_, jj) do { const int j_ = (jj); const LAS char* kb_ = (const LAS char*)lds + (j_ & 3) * STAGE; \
        if (MASKED) { STG_MASK(j_, ba_, bb_); qk64<NKS, true>(SA_, SB_, qf, kb_, lane, Mask64Bits{ba_, bb_}); } \
        else if (2 * j_ + 1 < tw) qk64<NKS, false>(SA_, SB_, qf, kb_, lane, Mask64None{}); \
        else qk64<NKS, true>(SA_, SB_, qf, kb_, lane, Mask64Causal{2 * j_, 2 * j_ + 1, tw}); } while (0)
    if (PIPE) STG_QK(sa, sb, 0);
    for (int j = 0; j < nst; ++j) {
        if (j + 1 < nst) { if (j + 2 < nst) VMWAIT_NL(1); else VMWAIT(0); }
        asm volatile("s_barrier" ::: "memory");
        if (j + 3 < nst) STG_DMA(j + 3);
        const LAS char* cur = (const LAS char*)lds + (j & 3) * STAGE;
        const bool an = j + 1 < nst && 2 * (j + 1) <= tw, ac = 2 * j <= tw;
        if (!PIPE) { if (ac) { STG_QK(sa, sb, j); smpv64(st, sa, sb, cur + KIMG, lane); } }
        else {
        f32x16 sa2, sb2;
        if (an && ac && (MASKED || 2 * (j + 1) + 1 < tw)) {
            if (MASKED) { STG_MASK(j + 1, ba_, bb_); qk64<NKS, true>(sa2, sb2, qf, (const LAS char*)lds + ((j + 1) & 3) * STAGE, lane, Mask64Bits{ba_, bb_}); }
            else qk64<NKS, false>(sa2, sb2, qf, (const LAS char*)lds + ((j + 1) & 3) * STAGE, lane, Mask64None{});
            smpv64(st, sa, sb, cur + KIMG, lane);
        } else {
            if (an) STG_QK(sa2, sb2, j + 1);
            if (ac) smpv64(st, sa, sb, cur + KIMG, lane);
        }
        if (an) { sa = sa2; sb = sb2; }
        }
    }
#undef STG_QK
#undef VMWAIT_NL
#undef STG_MASK
#undef STG_DMA
#undef GLDS16
#undef GLDS4
    attn_store(st, orow, lane);
}
DI void phase_attn_shared(const Bufs& B, LAS unsigned char* lds, int G, int wave, int lane_in, int variant) {
    const int vcu = (G % 8 == 0) ? ((int)blockIdx.x & 7) * (G / 8) + ((int)blockIdx.x >> 3) : (int)blockIdx.x;
    for (int pc = vcu; pc < 256; pc += G) {
        const int xg = pc >> 5, qi_ = pc & 31;
#pragma unroll 1
        for (int k = 0; k < 4; ++k) {
            int lane = lane_in; asm volatile("" : "+v"(lane));
            const int bh = 2 * xg + (k & 1), b = bh >> 2, h = bh & 3;
            const int Q = (k & 1) ? 31 - qi_ : qi_; const int n = lane & 31;
            const size_t qrow = (size_t)b * S + 256 * Q + 32 * wave + n;
            if (k < 2) attn_shared_unit<6, false, false>(lds, B.QM() + (qrow * 4 + h) * 96, (const char*)(B.KM() + ((size_t)b * S * 4 + h) * 96), 768, (const char*)(B.VM() + ((size_t)b * S * 4 + h) * 64), 512,
                                                  nullptr, variant ? (bf16_t*)(B.ws + OFF_DUMP) + lane * 64 : B.MIX() + qrow * D + h * 64, Q, wave, lane, variant);
            else attn_shared_unit<4, true, true>(lds, B.SQ() + (qrow * 4 + h) * 64, (const char*)(B.SK() + ((size_t)b * S * 4 + h) * 64), 512, (const char*)(B.SV() + ((size_t)b * S * 4 + h) * 64), 512,
                                           (const unsigned*)(B.ws + OFF_MASKG) + maskg_word(b, 8 * Q + wave, 0), variant ? (bf16_t*)(B.ws + OFF_DUMP) + lane * 64 : B.MIX() + qrow * D + 768 + h * 64, Q, wave, lane, variant);
        }
    }
    __syncthreads();
}

DI void phase_dil(const Bufs& B, LAS unsigned char* lds, int gw, int NGW, int wave, int lane) {
    LAS char* kl = (LAS char*)lds + wave * (4096 + VT_BYTES); LAS char* vl = kl + 4096;
    const int hi = lane >> 5, n = lane & 31;
    for (int task = gw; task < NB * 8 * 16 * 16; task += NGW) {
        const int ib = task & 15, r16 = (task >> 4) & 15, hd = (task >> 8) & 7, b = task >> 11;
        const int tq = r16 + 16 * (32 * ib + n);
        const size_t qrow = (size_t)b * S + tq;
        bf16x8 qf[4];
#pragma unroll
        for (int s = 0; s < 4; ++s) qf[s] = *(const bf16x8*)(B.DQ() + (qrow * 8 + hd) * 64 + 16 * s + 8 * hi);
        AttnState st; attn_init(st);
        const rsrc_t kr = make_rsrc(B.DK() + ((size_t)b * S * 8 + hd) * 64), vr = make_rsrc(B.DV() + ((size_t)b * S * 8 + hd) * 64);
#pragma unroll 1
        for (int pr = 0; pr < 3; ++pr) {
            const int stride = pr == 0 ? 16 : (pr == 1 ? 4 : 1), ntile = pr == 0 ? 5 : (pr == 1 ? 8 : 20);
            const int base0 = pr == 0 ? r16 + 16 * (32 * ib - 128) : (pr == 1 ? (r16 & 3) + 4 * ((r16 >> 2) + 128 * ib - 128) : r16 + 512 * ib - 128);
            KVTile<4> T;
            { unsigned ko[4];
#pragma unroll
              for (int j = 0; j < 4; ++j) { int tk = base0 + stride * ((lane >> 3) + 8 * j); tk = tk < 0 ? 0 : (tk > S - 1 ? S - 1 : tk); ko[j] = (unsigned)(tk * 1024 + (lane & 7) * 16); }
              kv_load<4>(T, kr, ko, 0, vr, ko, 0); }
            for (int u = 0; u < ntile; ++u) {
                const int base = base0 + stride * 32 * u;
                KVTile<4> Tn;
                if (u + 1 < ntile) { unsigned ko[4];
#pragma unroll
                    for (int j = 0; j < 4; ++j) { int tk = base + stride * 32 + stride * ((lane >> 3) + 8 * j); tk = tk < 0 ? 0 : (tk > S - 1 ? S - 1 : tk); ko[j] = (unsigned)(tk * 1024 + (lane & 7) * 16); }
                    kv_load<4>(Tn, kr, ko, 0, vr, ko, 0); }
                attn_tile<4>(st, qf, T, kl, vl, lane, MaskWin{tq - base - 8 * hi * stride, stride, (unsigned)min(128 * stride, tq)});
                T = Tn;
            }
        }
        attn_store(st, B.MIX() + qrow * D + 256 + hd * 64, lane);
    }
}

constexpr int D2_KV = 4096 + VT_BYTES, D2_OBUF = 8 * D2_KV, D2_OSTR = 136, D2_ML = D2_OBUF + 512 * D2_OSTR;
static_assert(D2_ML + 512 * 8 <= LDS_MISC, "dilated LDS map");
DI void phase_dil2(const Bufs& B, LAS unsigned char* lds, int G, int wave, int lane_in) {
    const int vcu = (G % 8 == 0) ? ((int)blockIdx.x & 7) * (G / 8) + ((int)blockIdx.x >> 3) : (int)blockIdx.x;
    LAS char* kl = (LAS char*)lds + wave * D2_KV; LAS char* vl = kl + 4096;
    for (int unit = vcu; unit < NB * 8 * 16; unit += G) {
        const int sp = unit & 15, hd = (unit >> 4) & 7, b = unit >> 7, T0 = 512 * sp;
        const rsrc_t kr = make_rsrc(B.DK() + ((size_t)b * S * 8 + hd) * 64), vr = make_rsrc(B.DV() + ((size_t)b * S * 8 + hd) * 64);
        __syncthreads();
#pragma unroll 1
        for (int pr = 0; pr < 3; ++pr) {
            const int stride = pr == 0 ? 16 : (pr == 1 ? 4 : 1);
#pragma unroll 1
            for (int tk = wave; tk < 16; tk += 8) {
                int lane = lane_in; asm volatile("" : "+v"(lane));
                const int hi = lane >> 5, n = lane & 31;
                const int tf = pr == 0 ? T0 + tk : (pr == 1 ? T0 + (tk & 3) + 128 * (tk >> 2) : T0 + 32 * tk);
                const int tq = tf + stride * n; const size_t qrow = (size_t)b * S + tq;
                bf16x8 qf[4];
#pragma unroll
                for (int s4 = 0; s4 < 4; ++s4) qf[s4] = *(const bf16x8*)(B.DQ() + (qrow * 8 + hd) * 64 + 16 * s4 + 8 * hi);
                AttnState st; attn_init(st); st.m = -1e20f;
                const int base0 = tf - 128 * stride;
                KVTile<4> T;
                { unsigned ko[4];
#pragma unroll
                  for (int j = 0; j < 4; ++j) { int t2 = base0 + stride * ((lane >> 3) + 8 * j); t2 = t2 < 0 ? 0 : t2; ko[j] = (unsigned)(t2 * 1024 + (lane & 7) * 16); }
                  kv_load<4>(T, kr, ko, 0, vr, ko, 0); }
#pragma unroll 1
                for (int u = 0; u < 5; ++u) {
                    const int base = base0 + stride * 32 * u;
                    KVTile<4> Tn;
                    if (u < 4) { unsigned ko[4];
#pragma unroll
                        for (int j = 0; j < 4; ++j) { int t2 = base + stride * 32 + stride * ((lane >> 3) + 8 * j); t2 = t2 < 0 ? 0 : (t2 > S - 1 ? S - 1 : t2); ko[j] = (unsigned)(t2 * 1024 + (lane & 7) * 16); }
                        kv_load<4>(Tn, kr, ko, 0, vr, ko, 0); }
                    attn_tile<4>(st, qf, T, kl, vl, lane, MaskWin{tq - base - 8 * hi * stride, stride, (unsigned)min(128 * stride, tq)});
                    T = Tn;
                }
                LAS char* orow = (LAS char*)lds + D2_OBUF + (tq - T0) * D2_OSTR + 8 * hi;
                LAS f32x2* mlp = (LAS f32x2*)(lds + D2_ML) + (tq - T0);
                float lt = st.l + shfl_xor_l(st.l, 32, lane);
                if (pr > 0) {
                    const f32x2 ml = *mlp; const float mn = fmaxf(st.m, ml[0]);
                    const float a1 = __builtin_amdgcn_exp2f(st.m - mn), a2 = __builtin_amdgcn_exp2f(ml[0] - mn);
                    lt = lt * a1 + ml[1] * a2; st.m = mn;
#pragma unroll
                    for (int rg = 0; rg < 4; ++rg) {
                        const u32x2 p0 = *(const LAS u32x2*)(orow + 16 * rg), p1 = *(const LAS u32x2*)(orow + 64 + 16 * rg);
#pragma unroll
                        for (int e = 0; e < 4; ++e) {
                            const float f0 = __uint_as_float(((e & 1) ? (e < 2 ? p0.x : p0.y) & 0xffff0000u : (e < 2 ? p0.x : p0.y) << 16));
                            const float f1 = __uint_as_float(((e & 1) ? (e < 2 ? p1.x : p1.y) & 0xffff0000u : (e < 2 ? p1.x : p1.y) << 16));
                            st.o0[4 * rg + e] = st.o0[4 * rg + e] * a1 + f0 * a2; st.o1[4 * rg + e] = st.o1[4 * rg + e] * a1 + f1 * a2;
                        }
                    }
                }
                if (pr < 2) {
#pragma unroll
                    for (int rg = 0; rg < 4; ++rg) {
                        *(LAS u32x2*)(orow + 16 * rg) = pk4((f32x4){st.o0[4 * rg], st.o0[4 * rg + 1], st.o0[4 * rg + 2], st.o0[4 * rg + 3]});
                        *(LAS u32x2*)(orow + 64 + 16 * rg) = pk4((f32x4){st.o1[4 * rg], st.o1[4 * rg + 1], st.o1[4 * rg + 2], st.o1[4 * rg + 3]});
                    }
                    if (hi == 0) *mlp = (f32x2){st.m, lt};
                } else {
                    const float inv = 1.f / lt; bf16_t* og = B.MIX() + qrow * D + 256 + hd * 64;
#pragma unroll
                    for (int rg = 0; rg < 4; ++rg) {
                        *(u32x2*)(og + 8 * rg + 4 * hi) = pk4((f32x4){st.o0[4 * rg] * inv, st.o0[4 * rg + 1] * inv, st.o0[4 * rg + 2] * inv, st.o0[4 * rg + 3] * inv});
                        *(u32x2*)(og + 32 + 8 * rg + 4 * hi) = pk4((f32x4){st.o1[4 * rg] * inv, st.o1[4 * rg + 1] * inv, st.o1[4 * rg + 2] * inv, st.o1[4 * rg + 3] * inv});
                    }
                }
            }
            __syncthreads();
        }
    }
    __syncthreads();
}

constexpr int DSA_CAP = 576;
constexpr int DL_HIST = 0;
constexpr int DL_CAND = 0, DL_WHIST = 32 * DSA_CAP * 8;
constexpr int DL_MISC = DL_WHIST + 16 * 512;
static_assert(DL_MISC + 2048 <= LDS_MISC, "DSA LDS map");
DI unsigned sortable_u(float f) { const unsigned u = __float_as_uint(f); return u ^ ((unsigned)((int)u >> 31) | 0x80000000u); }
DI void idx_scores(f32x16& sc, const bf16x8 (&kif)[2], const bf16x8 (&q)[8][2], const bf16x8 (&qt)[2], const float* whp  ) {
    const f32x4 wa = *(const f32x4*)whp, wb = *(const f32x4*)(whp + 4); const float wh[8] = {wa[0], wa[1], wa[2], wa[3], wb[0], wb[1], wb[2], wb[3]};
#pragma unroll
    for (int r = 0; r < 16; ++r) sc[r] = 0.f;
    sc = MFMA32(kif[0], qt[0], sc); sc = MFMA32(kif[1], qt[1], sc);
    f32x16 d[8];
#pragma unroll
    for (int hh = 0; hh < 8; ++hh) {
#pragma unroll
        for (int r = 0; r < 16; ++r) d[hh][r] = 0.f;
        d[hh] = MFMA32(kif[0], q[hh][0], d[hh]); d[hh] = MFMA32(kif[1], q[hh][1], d[hh]);
    }
    asm volatile("s_nop 7\n\ts_nop 3\n\tv_fma_f32 %0, |%1|, %2, %0" : "+v"(sc[0]) : "v"(d[0][0]), "v"(wh[0]), "v"(d[1][15]), "v"(d[2][15]), "v"(d[3][15]), "v"(d[4][15]), "v"(d[5][15]), "v"(d[6][15]), "v"(d[7][15]));
#pragma unroll
    for (int hh = 0; hh < 8; ++hh)
#pragma unroll
        for (int r = (hh == 0 ? 1 : 0); r < 16; ++r) asm volatile("v_fma_f32 %0, |%1|, %2, %0" : "+v"(sc[r]) : "v"(d[hh][r]), "v"(wh[hh]));
}
DI int wave_excl_scan(int x, int lane) {
    int v = x;
#pragma unroll
    for (int d = 1; d < 64; d <<= 1) { const int o = __builtin_amdgcn_ds_bpermute((lane - d) << 2, v); if (lane >= d) v += o; }
    return v - x;
}

DI void phase_dsa(const Bufs& B, LAS unsigned char* lds, int G, int wave, int lane_in) {
    LAS int* thrbin = (LAS int*)(lds + DL_MISC); LAS int* need = thrbin + 32; LAS unsigned* cnt = (LAS unsigned*)(need + 32); LAS u64* thr = (LAS u64*)(lds + DL_MISC + 512);
    for (int pi = blockIdx.x; pi < 512; pi += G) {
#pragma unroll 1
        for (int half = 0; half < 2; ++half) {
            int lane = lane_in; asm volatile("" : "+v"(lane));
            const int hi = lane >> 5, n = lane & 31, tid = wave * 64 + lane;
            const int b = pi >> 7, i = pi & 127, qb = half == 0 ? i : 255 - i;
            const int tq = 32 * qb + n; const size_t qrow = (size_t)b * S + tq;
            unsigned* maskw = (unsigned*)(B.ws + OFF_MASKG) + maskg_word(b, qb, 0);
            __syncthreads();
            {
            float w[8];
            { const f32x4 w0 = *(const f32x4*)(B.WI() + qrow * 8), w1 = *(const f32x4*)(B.WI() + qrow * 8 + 4);
              w[0] = w0[0]; w[1] = w0[1]; w[2] = w0[2]; w[3] = w0[3]; w[4] = w1[0]; w[5] = w1[1]; w[6] = w1[2]; w[7] = w1[3]; }
            bf16x8 qi[8][2];
#pragma unroll
            for (int hh = 0; hh < 8; ++hh)
#pragma unroll
                for (int s = 0; s < 2; ++s) qi[hh][s] = *(const bf16x8*)(B.QI() + (qrow * 8 + hh) * 32 + 16 * s + 8 * hi);
            bf16x8 qt[2];
#pragma unroll
            for (int s2 = 0; s2 < 2; ++s2) { float a8[8];
#pragma unroll
                for (int j = 0; j < 8; ++j) a8[j] = 0.f;
#pragma unroll
                for (int hh = 0; hh < 8; ++hh)
#pragma unroll
                    for (int j = 0; j < 8; ++j) a8[j] += w[hh] * bf2f((bf16_t)qi[hh][s2][j]);
                u32x4 pw; pw.x = pk2(a8[0], a8[1]); pw.y = pk2(a8[2], a8[3]); pw.z = pk2(a8[4], a8[5]); pw.w = pk2(a8[6], a8[7]); qt[s2] = __builtin_bit_cast(bf16x8, pw); }
            const float* whp = B.WI() + qrow * 8;
#define DSA_KIB() const bf16_t* kib; { int l2_ = lane_in; asm volatile("" : "+v"(l2_)); kib = B.KI() + ((size_t)b * S + keyperm(l2_ & 31)) * 32 + 8 * (l2_ >> 5); }
#ifndef DSA_REP_A
#define DSA_REP_A 1
#endif
#ifndef DSA_REP_B
#define DSA_REP_B 1
#endif
#ifndef DSA_REP_C
#define DSA_REP_C 1
#endif
            for (int repa_ = 0; repa_ < DSA_REP_A; ++repa_) {
            __syncthreads();
            { LAS u32x4* h4 = (LAS u32x4*)(lds + DL_HIST); unsigned zz = 0u; asm volatile("" : "+v"(zz)); const u32x4 z = {zz, zz, zz, zz};
#pragma unroll
              for (int k = 0; k < 16; ++k) h4[tid + 512 * k] = z; }
            __syncthreads();
            DSA_KIB()
            for (int kt0 = wave; kt0 <= qb; kt0 += 8) {
              bf16x8 kb4[1][2];
#pragma unroll
              for (int i4 = 0; i4 < 1; ++i4) { const int ktc = min(kt0 + 8 * i4, qb); kb4[i4][0] = *(const bf16x8*)(kib + (size_t)ktc * 32 * 32); kb4[i4][1] = *(const bf16x8*)(kib + (size_t)ktc * 32 * 32 + 16); }
#pragma unroll
              for (int i4 = 0; i4 < 1; ++i4) { const int kt = kt0 + 8 * i4; if (kt > qb) break;
                bf16x8 kif[2]; kif[0] = kb4[i4][0]; kif[1] = kb4[i4][1];
                int wo_ = 0; asm volatile("" : "+v"(wo_)); f32x16 sc; idx_scores(sc, kif, qi, qt, whp + wo_);
                int lq_ = lane_in; asm volatile("" : "+v"(lq_));
                const int lim = 32 * qb + (lq_ & 31) - 32 * kt - 8 * (lq_ >> 5);
#pragma unroll
                for (int r = 0; r < 16; ++r) { const unsigned bin = sortable_u(sc[r]) >> 21;
                    atomicAdd((unsigned*)(lds + DL_HIST + 4 * (n * 1024 + (bin >> 1))), 1u << (16 * (bin & 1))); }
                if (kt == qb) {
#pragma unroll
                    for (int r = 0; r < 16; ++r) { const unsigned bin = sortable_u(sc[r]) >> 21;
                        if (16 * (r >> 3) + (r & 7) > lim) atomicAdd((unsigned*)(lds + DL_HIST + 4 * (n * 1024 + (bin >> 1))), 0u - (1u << (16 * (bin & 1)))); } }
              }
            }
            }
            __syncthreads();
#pragma unroll 1
            for (int rp = 0; rp < 2; ++rp) {
                int ln = lane_in; asm volatile("" : "+v"(ln));
                const int row0 = wave * 4 + 2 * rp;
                const int wbase = 1023 - 16 * ln - 15;
                unsigned wds[2][16]; int cs[2];
#pragma unroll
                for (int q = 0; q < 2; ++q) { const LAS unsigned* hw = (const LAS unsigned*)(lds + DL_HIST) + (row0 + q) * 1024 + wbase;
#pragma unroll
                    for (int k = 0; k < 4; ++k) { const u32x4 v = *(const LAS u32x4*)(hw + 4 * k); wds[q][4 * k] = v.x; wds[q][4 * k + 1] = v.y; wds[q][4 * k + 2] = v.z; wds[q][4 * k + 3] = v.w; } }
#pragma unroll
                for (int q = 0; q < 2; ++q) { int c = 0;
#pragma unroll
                    for (int k = 0; k < 16; ++k) c += (int)(wds[q][k] & 0xffffu) + (int)(wds[q][k] >> 16);
                    cs[q] = c; }
                int v0 = cs[0], v1 = cs[1];
#pragma unroll
                for (int d = 1; d < 64; d <<= 1) { const int o0 = __builtin_amdgcn_ds_bpermute((ln - d) << 2, v0), o1 = __builtin_amdgcn_ds_bpermute((ln - d) << 2, v1); if (ln >= d) { v0 += o0; v1 += o1; } }
                const int pres[2] = {v0 - cs[0], v1 - cs[1]};
#pragma unroll
                for (int q = 0; q < 2; ++q) { const int row = row0 + q; const int total = 32 * qb + row + 1; int pre = pres[q];
                    if (total <= 256) { if (ln == 0) { thrbin[row] = -1; need[row] = 0; } }
                    else if (pre < 256 && pre + cs[q] >= 256) {
                        int tb = 0, nd = 1; bool found = false;
#pragma unroll
                        for (int k = 15; k >= 0; --k) {
                            const int bh = (int)(wds[q][k] >> 16), bl = (int)(wds[q][k] & 0xffffu); const int binh = 2 * (wbase + k) + 1;
                            if (!found) { if (pre + bh >= 256) { tb = binh; nd = 256 - pre; found = true; } else pre += bh; }
                            if (!found) { if (pre + bl >= 256) { tb = binh - 1; nd = 256 - pre; found = true; } else pre += bl; }
                        }
                        thrbin[row] = tb; need[row] = nd;
                    } }
            }
            for (int repb_ = 0; repb_ < DSA_REP_B; ++repb_) {
            __syncthreads();
            if (tid < 32) cnt[tid] = 0u;
            __syncthreads();
            { const int tb = thrbin[n]; DSA_KIB()
              for (int kt0 = wave; kt0 <= qb; kt0 += 8) {
               bf16x8 kb4[1][2];
#pragma unroll
               for (int i4 = 0; i4 < 1; ++i4) { const int ktc = min(kt0 + 8 * i4, qb); kb4[i4][0] = *(const bf16x8*)(kib + (size_t)ktc * 32 * 32); kb4[i4][1] = *(const bf16x8*)(kib + (size_t)ktc * 32 * 32 + 16); }
#pragma unroll
               for (int i4 = 0; i4 < 1; ++i4) { const int kt = kt0 + 8 * i4; if (kt > qb) break;
                bf16x8 kif[2]; kif[0] = kb4[i4][0]; kif[1] = kb4[i4][1];
                int wo_ = 0; asm volatile("" : "+v"(wo_)); f32x16 sc; idx_scores(sc, kif, qi, qt, whp + wo_);
                unsigned b16 = 0u;
                int lq_ = lane_in; asm volatile("" : "+v"(lq_));
                const int lim = 32 * qb + (lq_ & 31) - 32 * kt - 8 * (lq_ >> 5), kbase = 8191 - 32 * kt - 8 * (lq_ >> 5);
                unsigned c16 = 0u;
#pragma unroll
                for (int r = 0; r < 16; ++r) { const int bin = (int)(sortable_u(sc[r]) >> 21);
                    b16 |= bin > tb ? 1u << r : 0u; c16 |= bin == tb ? 1u << r : 0u; }
                {
                  unsigned okm = 0xffffu;
                  if (kt == qb) { const int ld = (lq_ & 31) - 8 * (lq_ >> 5);
                      const unsigned lo8 = ld < 0 ? 0u : (ld >= 7 ? 0xffu : (2u << ld) - 1u), l2 = ld - 16; const unsigned hi8 = (int)l2 < 0 ? 0u : ((int)l2 >= 7 ? 0xffu : (2u << l2) - 1u);
                      okm = lo8 | (hi8 << 8); }
                  b16 &= okm; c16 &= okm; }
                if (c16 != 0u) {
                    unsigned pos = atomicAdd((unsigned*)&cnt[n], (unsigned)__builtin_popcount(c16));
#pragma unroll
                    for (int r = 0; r < 16; ++r) if ((c16 >> r) & 1u) {
                        if (pos < (unsigned)DSA_CAP) *(LAS u64*)(lds + DL_CAND + ((size_t)n * DSA_CAP + pos) * 8) = ((u64)sortable_u(sc[r]) << 13) | (u64)(kbase - (16 * (r >> 3) + (r & 7)));
                        ++pos; } }
                unsigned mw = ((b16 & 0xffu) << (8 * hi)) | ((b16 >> 8) << (16 + 8 * hi));
                mw |= (unsigned)__builtin_amdgcn_ds_bpermute((lane ^ 32) << 2, (int)mw);
                if (hi == 0) maskw[kt * 32 + n] = mw;
               }
              } }
            }
            asm volatile("s_waitcnt vmcnt(0)" ::: "memory");
            __syncthreads();
#pragma unroll 1
            for (int rp = 0; rp < 2; ++rp) {
                int ln = lane_in; asm volatile("" : "+v"(ln));
                int tb[2], c[2], nd[2]; u64 pref[2]; u64 kk[2][9];
#pragma unroll
                for (int q = 0; q < 2; ++q) { const int row = wave * 4 + 2 * rp + q; tb[q] = thrbin[row];
                    c[q] = tb[q] < 0 ? 0 : min((int)cnt[row], DSA_CAP); nd[q] = need[row]; if (nd[q] > c[q]) nd[q] = c[q];
                    pref[q] = (u64)(unsigned)(tb[q] < 0 ? 0 : tb[q]) << 34;
                    const LAS u64* cl = (const LAS u64*)(lds + DL_CAND) + (size_t)row * DSA_CAP;
#pragma unroll
                    for (int j = 0; j < 9; ++j) { const int e = ln + 64 * j; const u64 k = cl[e < c[q] ? e : ln]; kk[q][j] = e < c[q] ? k : 0ull; } }
                if (c[0] == 0 && c[1] == 0) continue;
#pragma unroll
                for (int ps = 0; ps < 5; ++ps) {
                    const int sh = ps == 0 ? 27 : ps == 1 ? 20 : ps == 2 ? 13 : ps == 3 ? 6 : 0, nbt = ps == 4 ? 6 : 7;
                    int b1[2], b0[2];
#pragma unroll
                    for (int q = 0; q < 2; ++q) { LAS unsigned* wh = (LAS unsigned*)(lds + DL_WHIST + (wave * 2 + q) * 512); wh[ln] = 0u; wh[ln + 64] = 0u; }
#pragma unroll
                    for (int q = 0; q < 2; ++q) { LAS unsigned* wh = (LAS unsigned*)(lds + DL_WHIST + (wave * 2 + q) * 512);
#pragma unroll
                        for (int j = 0; j < 9; ++j) { const u64 k = kk[q][j]; if (ln + 64 * j < c[q] && (k >> (sh + nbt)) == (pref[q] >> (sh + nbt))) atomicAdd((unsigned*)&wh[(unsigned)(k >> sh) & ((1u << nbt) - 1u)], 1u); } }
#pragma unroll
                    for (int q = 0; q < 2; ++q) { const LAS unsigned* wh = (const LAS unsigned*)(lds + DL_WHIST + (wave * 2 + q) * 512); b1[q] = (int)wh[127 - 2 * ln]; b0[q] = (int)wh[126 - 2 * ln]; }
                    int v0 = b1[0] + b0[0], v1 = b1[1] + b0[1]; const int x0 = v0, x1 = v1;
#pragma unroll
                    for (int d = 1; d < 64; d <<= 1) { const int o0 = __builtin_amdgcn_ds_bpermute((ln - d) << 2, v0), o1 = __builtin_amdgcn_ds_bpermute((ln - d) << 2, v1); if (ln >= d) { v0 += o0; v1 += o1; } }
                    const int pre[2] = {v0 - x0, v1 - x1}, cl2[2] = {x0, x1};
#pragma unroll
                    for (int q = 0; q < 2; ++q) {
                        int dig = -1, used = 0;
                        if (pre[q] < nd[q] && pre[q] + cl2[q] >= nd[q]) { if (pre[q] + b1[q] >= nd[q]) { dig = 127 - 2 * ln; used = pre[q]; } else { dig = 126 - 2 * ln; used = pre[q] + b1[q]; } }
                        const u64 ball = __ballot(dig >= 0); const int src = (int)__builtin_ctzll(ball | (1ull << 63));
                        dig = __builtin_amdgcn_readlane(dig, src); used = __builtin_amdgcn_readlane(used, src);
                        if (dig < 0) dig = 0;
                        pref[q] |= (u64)(unsigned)dig << sh; nd[q] -= used; }
                }
#pragma unroll
                for (int q = 0; q < 2; ++q) { const int row = wave * 4 + 2 * rp + q;
#pragma unroll
                    for (int j = 0; j < 9; ++j) { const u64 k = kk[q][j]; if (ln + 64 * j < c[q] && k >= pref[q]) { const int key = 8191 - (int)(k & 8191u); atomicOr((unsigned*)&maskw[(key >> 5) * 32 + row], 1u << (key & 31)); } } }
            }
            }
            __syncthreads();
        }
    }
    __syncthreads();
}
DI float wave_max_l(float v, int lane) {
#pragma unroll
    for (int o = 32; o > 0; o >>= 1) v = fmaxf(v, shfl_xor_l(v, o, lane));
    return v;
}
DI void wave_merge_store_l(float m, float l, float* o, bf16_t* out, int lane) {
    const float mall = wave_max_l(m, lane); const float f = exp2f(m - mall);
    l = wave_sum_l(l * f, lane); const float inv = 1.f / l;
    float mine = 0.f;
#pragma unroll
    for (int d = 0; d < 64; ++d) { const float v = wave_sum_l(o[d] * f, lane); if (lane == d) mine = v; }
    out[lane] = f2bf(mine * inv);
}
DI void nphase_mla(const Bufs& B, int gw, int NGW, int lane) {
    for (size_t task = gw; task < (size_t)M * 4; task += NGW) {
        const size_t row = task >> 2; const int h = (int)(task & 3); const int b = (int)(row / S), t = (int)(row % S);
        float q[96]; load_q<96>(q, B.QM() + (row * 4 + h) * 96);
        float m = -1e30f, l = 0.f, o[64];
#pragma unroll
        for (int d = 0; d < 64; ++d) o[d] = 0.f;
        for (int s = lane; s <= t; s += 64) {
            const size_t kr = (size_t)b * S + s;
            const float sc = dot_bf16<96>(q, B.KM() + (kr * 4 + h) * 96);
            const float mn = fmaxf(m, sc), a = exp2f(m - mn), p = exp2f(sc - mn);
            l = l * a + p; acc_v64(o, a, p, B.VM() + (kr * 4 + h) * 64); m = mn;
        }
        wave_merge_store_l(m, l, o, B.MIX() + row * D + h * 64, lane);
    }
}
DI void nphase_dil(const Bufs& B, int gw, int NGW, int lane) {
    for (size_t task = gw; task < (size_t)M * 8; task += NGW) {
        const size_t row = task >> 3; const int h = (int)(task & 7); const int b = (int)(row / S), t = (int)(row % S);
        float q[64]; load_q<64>(q, B.DQ() + (row * 8 + h) * 64);
        float m = -1e30f, l = 0.f, o[64];
#pragma unroll
        for (int d = 0; d < 64; ++d) o[d] = 0.f;
        for (int idx = lane; idx < 387; idx += 64) {
            const int p = idx / 129, j = idx % 129; const int dil = p == 0 ? 1 : (p == 1 ? 4 : 16);
            const int s = t - j * dil;
            if (s >= 0) {
                const size_t kr = (size_t)b * S + s;
                const float sc = dot_bf16<64>(q, B.DK() + (kr * 8 + h) * 64);
                const float mn = fmaxf(m, sc), a = exp2f(m - mn), pp = exp2f(sc - mn);
                l = l * a + pp; acc_v64(o, a, pp, B.DV() + (kr * 8 + h) * 64); m = mn;
            }
        }
        wave_merge_store_l(m, l, o, B.MIX() + row * D + 256 + h * 64, lane);
    }
}
DI void nphase_dsa(const Bufs& B, LAS unsigned char* lds, int G, int wave, int lane) {
    LAS float* sc = (LAS float*)lds;
    LAS float* qi = (LAS float*)(lds + 32768);
    LAS unsigned* hist = (LAS unsigned*)(lds + 32768 + 1024);
    LAS float* wsh = (LAS float*)(lds + 32768 + 2048);
    LAS unsigned* sv = (LAS unsigned*)(lds + 32768 + 2048 + 64);
    const int tid = wave * 64 + lane;
    for (int row_i = blockIdx.x; row_i < M; row_i += G) {
        const size_t row = row_i; const int b = (int)(row / S), t = (int)(row % S), n = t + 1;
        __syncthreads();
        if (tid < 256) qi[tid] = bf2f(B.QI()[row * 256 + tid]);
        if (tid < 8) wsh[tid] = B.WI()[row * 8 + tid];
        __syncthreads();
        for (int s = tid; s < n; s += NTHR) {
            float k[32]; load_q<32>(k, B.KI() + ((size_t)b * S + s) * 32);
            float score = 0.f;
#pragma unroll 1
            for (int h = 0; h < 8; ++h) { float d = 0.f;
#pragma unroll
                for (int dd = 0; dd < 32; ++dd) d += qi[h * 32 + dd] * k[dd];
                score += wsh[h] * fmaxf(d, 0.f); }
            sc[s] = score;
        }
        __syncthreads();
        u64 thr = 0ull;
        if (n > 256) {
            if (tid == 0) { unsigned z_ = 0u, n_ = 256u; asm volatile("" : "+v"(z_), "+v"(n_)); sv[0] = z_; sv[1] = z_; sv[2] = n_; }
            for (int p = 5; p >= 0; --p) {
                const int shift = 8 * p;
                if (tid < 256) hist[tid] = 0u;
                __syncthreads();
                const u64 pref = ((u64)sv[1] << 32) | sv[0];
                for (int s = tid; s < n; s += NTHR) { const u64 key = ((u64)sortable(sc[s]) << 13) | (u64)(8191 - s);
                    if ((key >> (shift + 8)) == (pref >> (shift + 8))) atomicAdd((unsigned*)&hist[(unsigned)(key >> shift) & 255u], 1u); }
                __syncthreads();
                if (tid == 0) { unsigned need = sv[2], cum = 0u; int dg = 255;
                    for (; dg > 0; --dg) { const unsigned c = hist[dg]; if (cum + c >= need) break; cum += c; }
                    const u64 np = pref | ((u64)dg << shift); sv[0] = (unsigned)np; sv[1] = (unsigned)(np >> 32); sv[2] = need - cum; }
                __syncthreads();
            }
            thr = ((u64)sv[1] << 32) | sv[0];
        }
        if (wave < 4) {
            const int h = wave;
            float q[64]; load_q<64>(q, B.SQ() + (row * 4 + h) * 64);
            float m = -1e30f, l = 0.f, o[64];
#pragma unroll
            for (int d = 0; d < 64; ++d) o[d] = 0.f;
            for (int s = lane; s < n; s += 64) {
                const u64 key = ((u64)sortable(sc[s]) << 13) | (u64)(8191 - s);
                if (key >= thr) {
                    const size_t kr = (size_t)b * S + s;
                    const float s2 = dot_bf16<64>(q, B.SK() + (kr * 4 + h) * 64);
                    const float mn = fmaxf(m, s2), a = exp2f(m - mn), p = exp2f(s2 - mn);
                    l = l * a + p; acc_v64(o, a, p, B.SV() + (kr * 4 + h) * 64); m = mn;
                }
            }
            wave_merge_store_l(m, l, o, B.MIX() + row * D + 768 + h * 64, lane);
        }
    }
    __syncthreads();
}
struct Inputs { const float *x, *g_attn, *w_in, *g_q_lat, *w_uq, *g_kv_lat, *w_ukv, *w_o, *g_ffn, *w_up, *conv_w, *conv_b, *w_down, *g_final; };
struct MkArgs { Bufs B; Inputs I; int ph_lo, ph_hi, use_bar, pad; };

DI Inputs load_inputs() { const __attribute__((address_space(4))) char* ka = (const __attribute__((address_space(4))) char*)__builtin_amdgcn_kernarg_segment_ptr(); asm volatile("" : "+s"(ka));
    typedef const float* fptr_t; const __attribute__((address_space(4))) fptr_t* pp = (const __attribute__((address_space(4))) fptr_t*)(ka + __builtin_offsetof(MkArgs, I));
    Inputs r; fptr_t* rp = (fptr_t*)&r;
#pragma unroll
    for (int i = 0; i < 14; ++i) rp[i] = pp[i];
    return r; }
constexpr int WK_N[5] = {NINP, NLAT, D, NUP, D};
constexpr int WK_K[5] = {D, KLAT, D, D, DFF};
DI float wval(const Inputs& I, int kind, int l, int n, int k, int up_perm) {
    switch (kind) {
        case 0: { const int sc = src_in(n, 1); return sc < 0 ? 0.f : I.w_in[((size_t)l * D + k) * NIN + sc] * I.g_attn[l * D + k]; }
        case 1: {
            if (n < 384) { if (k >= 256) return 0.f; int sc = n; if ((n % 96) >= 64) { const int g = n & ~31, ch = (n >> 2) & 7, e = n & 3; sc = g + 4 * ((ch >> 1) + 4 * (ch & 1)) + e; }
                return I.w_uq[((size_t)l * 256 + k) * 384 + sc] * I.g_q_lat[l * 256 + k]; }
            if (n < 896) { if (k < 256) return 0.f; return I.w_ukv[((size_t)l * 128 + (k - 256)) * 512 + (n - 384)] * I.g_kv_lat[l * 128 + (k - 256)]; }
            return 0.f; }
        case 2: return I.w_o[((size_t)l * D + k) * D + n];
        case 3: { int sc = n; if (up_perm) { const int pn = n >> 8, j = n & 255; sc = j < 128 ? 128 * pn + j : DFF + 128 * pn + (j - 128); } return I.w_up[((size_t)l * D + k) * NUP + sc] * I.g_ffn[l * D + k]; }
        default: return I.w_down[((size_t)l * DFF + k) * D + n];
    }
}
DI bf16_t* wptr(const Bufs& B, int l, int kind) {
    bf16_t* p = B.W() + (size_t)l * W_LAYER;
    if (kind >= 1) p += W_IN; if (kind >= 2) p += W_LAT; if (kind >= 3) p += W_O; if (kind >= 4) p += W_UP;
    return p;
}

DI void phase_prologue(const Bufs& B, const Inputs& I, LAS unsigned char* lds, int gw, int NGW, int wave, int lane, int up_perm) {
    for (int idx = gw * 64 + lane; idx < S * 28; idx += NGW * 64) {
        const int t = idx / 28, i = idx % 28;
        if (i < 16) { const float inv = powf(THETA, -(float)(2 * i) / 32.0f); const float a = (float)t * inv; B.cosA()[t * 16 + i] = cosf(a); B.sinA()[t * 16 + i] = sinf(a); }
        else if (i < 24) { const int j = i - 16; const float inv = powf(THETA, -(float)(2 * j) / 16.0f); const float a = (float)t * inv; B.cosH()[t * 8 + j] = cosf(a); B.sinH()[t * 8 + j] = sinf(a); }
        else { const int j = i - 24; const float inv = powf(THETA, -(float)(2 * j) / 8.0f); const float a = (float)t * inv; B.cosI()[t * 4 + j] = cosf(a); B.sinI()[t * 4 + j] = sinf(a); }
    }
    LAS float* scr = (LAS float*)(lds + LDS_STAGE + wave * 8704);
    int items_per_layer = 0;
#pragma unroll
    for (int kd = 0; kd < 5; ++kd) items_per_layer += (WK_N[kd] / 32) * (WK_K[kd] / 64);
#ifndef REP_PRO_W
#define REP_PRO_W 1
#endif
#ifndef REP_PRO_X
#define REP_PRO_X 1
#endif
    for (int rw_ = 0; rw_ < REP_PRO_W; ++rw_)
    for (int it = gw; it < items_per_layer * NL; it += NGW) {
        const int l = it / items_per_layer; int r = it % items_per_layer; int kind = 0;
#pragma unroll
        for (int kd = 0; kd < 4; ++kd) { const int cnt = (WK_N[kd] / 32) * (WK_K[kd] / 64); if (kind == kd && r >= cnt) { r -= cnt; kind = kd + 1; } }
        const int K = kind == 0 ? WK_K[0] : kind == 1 ? WK_K[1] : kind == 2 ? WK_K[2] : kind == 3 ? WK_K[3] : WK_K[4];
        const int N_ = kind == 0 ? WK_N[0] : kind == 1 ? WK_N[1] : kind == 2 ? WK_N[2] : kind == 3 ? WK_N[3] : WK_N[4];
        const int nnb = N_ / 32, nb = r % nnb, kb = r / nnb, n0 = nb * 32, k0 = kb * 64;
        { const int n = n0 + (lane & 31); const float* src; const float* gp = nullptr; int ld, col = n, koff = 0; bool iv = true; float lanev = 1.f;
          if (kind == 0) { const int sc = src_in(n, 1); col = sc < 0 ? 0 : sc; lanev = sc < 0 ? 0.f : 1.f; src = I.w_in + (size_t)l * D * NIN; ld = NIN; gp = I.g_attn + l * D; }
          else if (kind == 1) {
              if (n0 < 384) { iv = k0 < 256; if ((n % 96) >= 64) { const int g = n & ~31, ch = (n >> 2) & 7, e = n & 3; col = g + 4 * ((ch >> 1) + 4 * (ch & 1)) + e; }
                  src = I.w_uq + (size_t)l * 256 * 384; ld = 384; gp = I.g_q_lat + l * 256; }
              else if (n0 < 896) { iv = k0 >= 256; koff = -256; col = n - 384; src = I.w_ukv + (size_t)l * 128 * 512; ld = 512; gp = I.g_kv_lat + l * 128; }
              else { iv = false; src = I.w_uq; ld = 384; } }
          else if (kind == 2) { src = I.w_o + (size_t)l * D * D; ld = D; }
          else if (kind == 3) { if (up_perm) { const int pn = n >> 8, j = n & 255; col = j < 128 ? 128 * pn + j : DFF + 128 * pn + (j - 128); } src = I.w_up + (size_t)l * D * NUP; ld = NUP; gp = I.g_ffn + l * D; }
          else { src = I.w_down + (size_t)l * DFF * D; ld = D; }
          const int kb0 = k0 + koff + (lane >> 5);
          if (!iv) {
#pragma unroll
              for (int i = 0; i < 32; ++i) scr[(2 * i + (lane >> 5)) * 33 + (lane & 31)] = 0.f;
          } else if (gp) {
              float v[32], g[32];
#pragma unroll
              for (int i = 0; i < 32; ++i) { v[i] = src[(size_t)(kb0 + 2 * i) * ld + col]; g[i] = gp[kb0 + 2 * i]; }
#pragma unroll
              for (int i = 0; i < 32; ++i) scr[(2 * i + (lane >> 5)) * 33 + (lane & 31)] = v[i] * g[i] * lanev;
          } else {
              float v[32];
#pragma unroll
              for (int i = 0; i < 32; ++i) v[i] = src[(size_t)(kb0 + 2 * i) * ld + col];
#pragma unroll
              for (int i = 0; i < 32; ++i) scr[(2 * i + (lane >> 5)) * 33 + (lane & 31)] = v[i];
          } }
        asm volatile("s_waitcnt lgkmcnt(0)" ::: "memory");
        bf16_t* out = wptr(B, l, kind);
        const int c = lane & 7;
#pragma unroll
        for (int j = 0; j < 4; ++j) { const int n = (lane >> 3) + 8 * j; const LAS float* s = scr + (8 * c) * 33 + n;
            u32x4 o; o.x = pk2(s[0 * 33], s[1 * 33]); o.y = pk2(s[2 * 33], s[3 * 33]); o.z = pk2(s[4 * 33], s[5 * 33]); o.w = pk2(s[6 * 33], s[7 * 33]);
            *(u32x4*)(out + (size_t)(n0 + n) * K + k0 + 8 * c) = o; }
        asm volatile("s_waitcnt lgkmcnt(0)" ::: "memory");
    }
    for (int rx_ = 0; rx_ < REP_PRO_X; ++rx_)
    for (int row0 = gw; row0 < M; row0 += 2 * NGW) {
        const bool two = row0 + NGW < M; const int row1 = two ? row0 + NGW : row0;
        const f32x4* xa = (const f32x4*)(I.x + (size_t)row0 * D) + lane; const f32x4* xb = (const f32x4*)(I.x + (size_t)row1 * D) + lane;
        f32x4 va[4], vb[4]; float sa = 0.f, sb = 0.f;
#pragma unroll
        for (int j = 0; j < 4; ++j) { va[j] = xa[64 * j]; vb[j] = xb[64 * j]; }
#pragma unroll
        for (int j = 0; j < 4; ++j) { sa += (va[j][0] * va[j][0] + va[j][1] * va[j][1]) + (va[j][2] * va[j][2] + va[j][3] * va[j][3]); sb += (vb[j][0] * vb[j][0] + vb[j][1] * vb[j][1]) + (vb[j][2] * vb[j][2] + vb[j][3] * vb[j][3]); }
        sa = wave_sum_l(sa, lane); sb = wave_sum_l(sb, lane);
#pragma unroll
        for (int j = 0; j < 4; ++j) { ((f32x4*)(B.X() + (size_t)row0 * D))[lane + 64 * j] = va[j]; ((u32x2*)(B.XB() + (size_t)row0 * D))[lane + 64 * j] = pk4(va[j]); }
        if (lane < 4) B.RSP()[(size_t)row0 * 4 + lane] = lane == 0 ? sa : 0.f;
        if (two) {
#pragma unroll
            for (int j = 0; j < 4; ++j) { ((f32x4*)(B.X() + (size_t)row1 * D))[lane + 64 * j] = vb[j]; ((u32x2*)(B.XB() + (size_t)row1 * D))[lane + 64 * j] = pk4(vb[j]); }
            if (lane < 4) B.RSP()[(size_t)row1 * 4 + lane] = lane == 0 ? sb : 0.f; }
    }
}

DI void phase_final(const Bufs& B, const float* g_final, int gw, int NGW, int lane) {
    for (int row = gw; row < M; row += NGW) {
        const float rs = rs_of(B.RSP(), (size_t)row);
        f32x4* xr = (f32x4*)(B.X() + (size_t)row * D) + lane; const f32x4* gr = (const f32x4*)g_final + lane;
#pragma unroll
        for (int j = 0; j < 4; ++j) xr[64 * j] = xr[64 * j] * rs * gr[64 * j];
    }
}

#ifndef REP_P1
#define REP_P1 1
#endif
#ifndef REP_LAT
#define REP_LAT 1
#endif
#ifndef REP_DIL
#define REP_DIL 1
#endif
#ifndef REP_DSA
#define REP_DSA 1
#endif
#ifndef REP_MLA
#define REP_MLA 1
#endif
#ifndef REP_P5
#define REP_P5 1
#endif
__global__ void __launch_bounds__(NTHR, 2) mk(MkArgs A) {
    extern __shared__ __attribute__((aligned(16))) unsigned char lds_raw[];
    LAS unsigned char* lds = (LAS unsigned char*)lds_raw;
    const int wave = __builtin_amdgcn_readfirstlane(threadIdx.x >> 6);
    const int G = gridDim.x, NGW = G * NWAVES;
    volatile LAS unsigned* misc = (volatile LAS unsigned*)(lds + LDS_MISC);
    if (wave == 0 && lane_id() < 16) misc[lane_id()] = 0u;
    __syncthreads();
#define IS_T0 ((wave * 64 + lane_id()) == 0)
    XcdBarrier bar; bar.bar = A.B.CTL() + 1024; bar.x = 0; bar.st = misc;
    if (A.use_bar) bar = xcd_barrier_post(A.B.CTL() + 1024, misc, IS_T0);
    const int lo = A.ph_lo, hi = A.ph_hi;
#define IN(k) (lo <= (k) && (k) < hi)
#define SEAM(k) do { if (IN(k) && IN((k) + 1)) { XcdBarrier bb_ = bar; size_t z_ = 0; asm volatile("" : "+s"(z_)); bb_.bar = A.B.CTL() + 1024 + z_; xcd_barrier(bb_, IS_T0); } } while (0)
#define OPAQUE_BUFS(Bl) Bufs Bl = A.B; { size_t z_ = 0; asm volatile("" : "+s"(z_)); Bl.ws += z_; Bl.Xp = (float*)((char*)Bl.Xp + z_); }
#ifndef REP_PRO
#define REP_PRO 1
#endif
    for (int rep_ = 0; rep_ < REP_PRO; ++rep_) if (IN(0)) { int l_ = lane_id(); asm volatile("" : "+v"(l_)); const Inputs I_ = load_inputs(); phase_prologue(A.B, I_, lds, blockIdx.x * NWAVES + wave, NGW, wave, l_, UP_PERM); } SEAM(0);
    for (int l = 0; l < NL; ++l) {
        const int pb = 1 + 6 * l;
        for (int rep_ = 0; rep_ < REP_P1; ++rep_) if (IN(pb + 0)) {
            OPAQUE_BUFS(Bl);
            pg8::Gemm g{Bl.XB(), wptr(Bl, l, 0), M, NINP, D}; pg8::GridOrder So; So.init(M / 256, NINP / 256, G, (int)blockIdx.x);
            EpiInproj E{Bl, (LAS float*)(lds + LDS_HALO)};
            pg8::gemm_phase<EpiInproj, pg8::GridOrder, true, true>(lds + LDS_STAGE, g, So, E, wave);
        } SEAM(pb + 0);
        for (int rep_ = 0; rep_ < REP_LAT; ++rep_) if (IN(pb + 1)) {
            OPAQUE_BUFS(Bl);
            int klat = KLAT; asm volatile("" : "+s"(klat));
            pg8::Gemm g{Bl.CQKV(), wptr(Bl, l, 1), M, NLAT, klat}; pg8::GridOrder So; So.init(M / 256, NLAT / 256, G, (int)blockIdx.x);
            EpiLat E{Bl, (LAS float*)(lds + LDS_HALO)};
            pg8::gemm_phase<EpiLat, pg8::GridOrder, true, true>(lds + LDS_STAGE, g, So, E, wave);
        }
        if (IN(pb + 1)) {
            OPAQUE_BUFS(Bl); int l_ = lane_id(); asm volatile("" : "+v"(l_));
            for (int rep_ = 0; rep_ < REP_DIL; ++rep_) phase_dil2(Bl, lds, G, wave, l_);
            for (int rep_ = 0; rep_ < REP_DSA; ++rep_) phase_dsa(Bl, lds, G, wave, l_);
        }
        SEAM(pb + 1);
        if (IN(pb + 2)) { OPAQUE_BUFS(Bl); int l_ = lane_id(); asm volatile("" : "+v"(l_)); for (int rep_ = 0; rep_ < REP_MLA; ++rep_) phase_attn_shared(Bl, lds, G, wave, l_, rep_ > 0 ? ATT_VARIANT : 0); }
        SEAM(pb + 2);
#ifndef REP_P4
#define REP_P4 0
#endif
#ifndef REP_P6
#define REP_P6 0
#endif
        for (int rep_ = 0; rep_ < REP_P4; ++rep_) if (IN(pb + 3)) {
            OPAQUE_BUFS(Bl);
            pg8::Gemm g{Bl.MIX(), wptr(Bl, l, 2), M, D, D}; pg8::GridOrder So; So.init(M / 256, D / 256, G, (int)blockIdx.x);
            EpiResidT<true> E{Bl, (LAS float*)(lds + LDS_HALO)};
            pg8::gemm_phase<EpiResidT<true>, pg8::GridOrder, true, true>(lds + LDS_STAGE, g, So, E, wave);
        }
        if (IN(pb + 3)) {
            OPAQUE_BUFS(Bl);
            pg8::Gemm g{Bl.MIX(), wptr(Bl, l, 2), M, D, D}; pg8::GridOrder So; So.init(M / 256, D / 256, G, (int)blockIdx.x);
            EpiResid E{Bl, (LAS float*)(lds + LDS_HALO)};
            pg8::gemm_phase<EpiResid, pg8::GridOrder, true, true>(lds + LDS_STAGE, g, So, E, wave);
        } SEAM(pb + 3);
        for (int rep_ = 0; rep_ < REP_P5; ++rep_) if (IN(pb + 4)) {
            OPAQUE_BUFS(Bl);
            pg8::Gemm g{Bl.XB(), wptr(Bl, l, 3), M, NUP, D}; pg8::GridOrder So; So.init(M / 256, NUP / 256, G, (int)blockIdx.x);
            const Inputs I_ = load_inputs(); EpiConvAct E{Bl, I_.conv_w + (size_t)l * 3 * NUP, I_.conv_b + (size_t)l * NUP, (LAS float*)(lds + LDS_HALO)};
            pg8::gemm_phase<EpiConvAct, pg8::GridOrder, true, true>(lds + LDS_STAGE, g, So, E, wave);
        } SEAM(pb + 4);
        for (int rep_ = 0; rep_ < REP_P6; ++rep_) if (IN(pb + 5)) {
            OPAQUE_BUFS(Bl);
            pg8::Gemm g{Bl.ACT(), wptr(Bl, l, 4), M, D, DFF}; pg8::GridOrder So; So.init(M / 256, D / 256, G, (int)blockIdx.x);
            EpiResidT<true> E{Bl, (LAS float*)(lds + LDS_HALO)};
            pg8::gemm_phase<EpiResidT<true>, pg8::GridOrder, true, true>(lds + LDS_STAGE, g, So, E, wave);
        }
        if (IN(pb + 5)) {
            OPAQUE_BUFS(Bl);
            pg8::Gemm g{Bl.ACT(), wptr(Bl, l, 4), M, D, DFF}; pg8::GridOrder So; So.init(M / 256, D / 256, G, (int)blockIdx.x);
            {
              const Inputs I_ = load_inputs(); int l2_ = lane_id(); asm volatile("" : "+v"(l2_)); int lastpm = -1;
#pragma unroll 1
              for (int i = 0;; ++i) { int pmi; { pg8::Unit uu; pmi = So.next(i, uu) ? uu.pm : -1; }
                  if (pmi < 0) break;
                  if (pmi != lastpm) { conv_fixup(Bl, I_.conv_w + (size_t)l * 3 * NUP, I_.conv_b + (size_t)l * NUP, pmi, wave * 64 + l2_); lastpm = pmi; } }
              asm volatile("s_waitcnt vmcnt(0)" ::: "memory"); __syncthreads(); }
            EpiResid E{Bl, (LAS float*)(lds + LDS_HALO)};
            pg8::gemm_phase<EpiResid, pg8::GridOrder, true, true>(lds + LDS_STAGE, g, So, E, wave);
        } SEAM(pb + 5);
    }
    if (IN(25)) { int l_ = lane_id(); asm volatile("" : "+v"(l_)); const Inputs I_ = load_inputs(); phase_final(A.B, I_.g_final, blockIdx.x * NWAVES + wave, NGW, l_); }
#undef IN
#undef SEAM
#undef OPAQUE_BUFS
#undef IS_T0
}
extern "C" void kernel_launch(void* const* d_in, const int* in_sizes, int n_in, void* d_out, int out_size, void* d_ws, size_t ws_size, hipStream_t stream) {
    static int grid = 0;
    if (grid == 0) {
        int dev = 0, cus = 0, per_cu = 0; (void)hipGetDevice(&dev); (void)hipDeviceGetAttribute(&cus, hipDeviceAttributeMultiprocessorCount, dev);
        (void)hipFuncSetAttribute((const void*)mk, hipFuncAttributeMaxDynamicSharedMemorySize, LDS_BYTES);
        (void)hipOccupancyMaxActiveBlocksPerMultiprocessor(&per_cu, (const void*)mk, NTHR, LDS_BYTES);
        (void)hipGetLastError();
        grid = cus > 0 ? cus : 256;
    }
    MkArgs A{};
    A.B = make_bufs(d_out, d_ws);
    const float** ip = (const float**)&A.I;
    for (int i = 0; i < 14; ++i) ip[i] = (const float*)d_in[i];
    (void)hipMemsetAsync((char*)d_ws + OFF_CTL, 0, CTL_BYTES, stream);
    A.ph_lo = 0; A.ph_hi = 26; A.use_bar = 1; A.pad = 0;
    hipLaunchKernelGGL(mk, dim3(grid), dim3(NTHR), LDS_BYTES, stream, A);
}
```

```cpp
#include <hip/hip_runtime.h>
#include <stdint.h>

#define DI __device__ __forceinline__
#define LAS __attribute__((address_space(3)))
typedef unsigned short bf16_t;
typedef short bf16x8 __attribute__((ext_vector_type(8)));
typedef short s16x4 __attribute__((ext_vector_type(4)));
typedef float f32x4 __attribute__((ext_vector_type(4)));
typedef float f32x2 __attribute__((ext_vector_type(2)));
typedef float f32x16 __attribute__((ext_vector_type(16)));
typedef unsigned u32x4 __attribute__((ext_vector_type(4)));
typedef unsigned u32x2 __attribute__((ext_vector_type(2)));
typedef __bf16 bf16x2v __attribute__((ext_vector_type(2)));
typedef unsigned long long u64;

constexpr int NB = 4, S = 8192, D = 1024, NL = 4, M = NB * S;
constexpr int NIN = 3016, NINP = 3072, DFF = 2816, NUP = 2 * DFF, NLAT = 1024, KLAT = 384;
constexpr float EPS = 1e-6f;
constexpr float LOG2E = 1.4426950408889634f;
constexpr float THETA = 500000.0f;
constexpr float QSCALE_MLA = 0.10206207261596577f * LOG2E;
constexpr float QSCALE_64 = 0.125f * LOG2E;

DI bf16_t f2bf(float f) { unsigned u = __float_as_uint(f); u += 0x7fffu + ((u >> 16) & 1u); return (bf16_t)(u >> 16); }
DI float bf2f(bf16_t h) { return __uint_as_float(((unsigned)h) << 16); }
DI unsigned pk2(float lo, float hi) { f32x2 v = {lo, hi}; bf16x2v b = __builtin_convertvector(v, bf16x2v); return __builtin_bit_cast(unsigned, b); }
DI u32x4 pk8(f32x4 a, f32x4 b) { u32x4 w; w.x = pk2(a[0], a[1]); w.y = pk2(a[2], a[3]); w.z = pk2(b[0], b[1]); w.w = pk2(b[2], b[3]); return w; }
DI u32x2 pk4(f32x4 a) { u32x2 w; w.x = pk2(a[0], a[1]); w.y = pk2(a[2], a[3]); return w; }

constexpr size_t MiB = 1u << 20;
constexpr size_t OFF_CTL = 0;
constexpr size_t OFF_TAB = 1 * MiB;
constexpr size_t OFF_RS = 3 * MiB;
constexpr size_t OFF_W = 8 * MiB;
constexpr size_t OFF_XB = 110 * MiB;
constexpr size_t OFF_MIX = 174 * MiB;
constexpr size_t OFF_Z = 238 * MiB;
constexpr size_t CTL_BYTES = 1 * MiB;
constexpr size_t OFF_DUMP = 7 * MiB;

constexpr size_t W_IN = (size_t)NINP * D, W_LAT = (size_t)NLAT * KLAT, W_O = (size_t)D * D, W_UP = (size_t)NUP * D, W_DN = (size_t)D * DFF;
constexpr size_t W_LAYER = W_IN + W_LAT + W_O + W_UP + W_DN;
static_assert(OFF_W + W_LAYER * NL * 2 <= OFF_XB, "weights fit");

constexpr size_t ZQM = 0, ZVM = ZQM + (size_t)M * 768, ZCQKV = ZVM + (size_t)M * 512, ZKM = ZCQKV + (size_t)M * 768, ZDQ = ZKM + (size_t)M * 768,
                 ZDK = ZDQ + (size_t)M * 1024, ZDV = ZDK + (size_t)M * 1024, ZSQ = ZDV + (size_t)M * 1024, ZSK = ZSQ + (size_t)M * 512, ZSV = ZSK + (size_t)M * 512,
                 ZQI = ZSV + (size_t)M * 512, ZKI = ZQI + (size_t)M * 512, ZWI = ZKI + (size_t)M * 64, ZEND = ZWI + (size_t)M * 32;
static_assert(OFF_Z + ZEND <= 512 * MiB, "workspace map");
static_assert(OFF_Z + (size_t)M * DFF * 2 <= 512 * MiB, "ACT overlay");
constexpr size_t OFF_BND = OFF_Z + 180 * MiB;
static_assert(OFF_BND >= OFF_Z + (size_t)M * DFF * 2 && OFF_BND + (size_t)128 * 22 * 4 * 256 * 4 <= OFF_Z + ZEND, "conv boundary rows fit behind the ACT overlay");

struct Bufs {
    char* ws; float* Xp;
#define BUFP(T, name, off) DI T* name() const { return (T*)(ws + (off)); }
    DI float* X() const { return Xp; }
    BUFP(bf16_t, XB, OFF_XB)
    BUFP(float, RSP, OFF_RS)
    BUFP(float, RQP, OFF_RS + (size_t)M * 64)
    BUFP(float, RKVP, OFF_RS + (size_t)M * 96)
    BUFP(float, cosA, OFF_TAB) BUFP(float, sinA, OFF_TAB + S * 16 * 4) BUFP(float, cosH, OFF_TAB + S * 32 * 4) BUFP(float, sinH, OFF_TAB + S * 40 * 4)
    BUFP(float, cosI, OFF_TAB + S * 48 * 4) BUFP(float, sinI, OFF_TAB + S * 52 * 4)
    BUFP(bf16_t, W, OFF_W) BUFP(bf16_t, MIX, OFF_MIX)
    BUFP(bf16_t, QM, OFF_Z + ZQM) BUFP(bf16_t, VM, OFF_Z + ZVM) BUFP(bf16_t, CQKV, OFF_Z + ZCQKV) BUFP(bf16_t, KM, OFF_Z + ZKM)
    BUFP(bf16_t, DQ, OFF_Z + ZDQ) BUFP(bf16_t, DK, OFF_Z + ZDK) BUFP(bf16_t, DV, OFF_Z + ZDV)
    BUFP(bf16_t, SQ, OFF_Z + ZSQ) BUFP(bf16_t, SK, OFF_Z + ZSK) BUFP(bf16_t, SV, OFF_Z + ZSV)
    BUFP(bf16_t, QI, OFF_Z + ZQI) BUFP(bf16_t, KI, OFF_Z + ZKI) BUFP(float, WI, OFF_Z + ZWI)
    BUFP(bf16_t, ACT, OFF_Z)
    BUFP(char, Z, OFF_Z) BUFP(char, SCRA, OFF_MIX) BUFP(unsigned, CTL, OFF_CTL)
#undef BUFP
};
static Bufs make_bufs(void* d_out, void* d_ws) { Bufs B; B.ws = (char*)d_ws; B.Xp = (float*)d_out; return B; }

DI float shfl_xor_l(float v, int mask, int lane) { return __builtin_bit_cast(float, __builtin_amdgcn_ds_bpermute((lane ^ mask) << 2, __builtin_bit_cast(int, v))); }
DI int lane_id() { int l; asm volatile("v_mbcnt_lo_u32_b32 %0, -1, 0\n\tv_mbcnt_hi_u32_b32 %0, -1, %0" : "=v"(l)); return l; }
DI float wave_sum(float v) {
#pragma unroll
    for (int o = 32; o > 0; o >>= 1) v += __shfl_xor(v, o);
    return v;
}
DI float wave_sum_l(float v, int lane) {
#pragma unroll
    for (int o = 32; o > 0; o >>= 1) v += shfl_xor_l(v, o, lane);
    return v;
}
DI float wave_max(float v) {
#pragma unroll
    for (int o = 32; o > 0; o >>= 1) v = fmaxf(v, __shfl_xor(v, o));
    return v;
}
DI float block_sum_256(float v, float* sh) {
    v = wave_sum(v);
    __syncthreads();
    if ((threadIdx.x & 63) == 0) sh[threadIdx.x >> 6] = v;
    __syncthreads();
    return sh[0] + sh[1] + sh[2] + sh[3];
}
DI float rs_of(const float* RSP, size_t row) {
    const f32x4 a = *(const f32x4*)(RSP + row * 4);
    return rsqrtf(((a[0] + a[1]) + (a[2] + a[3])) * (1.f / (float)D) + EPS);
}
DI int src_in(int n, int perm) {
    if (n >= NIN) return -1;
    if (!perm) return n;
    const int g = n & ~31, ch = (n >> 2) & 7, e = n & 3;
    if (n >= 384 && n < 416) return g + 4 * ((ch >> 1) + 4 * (ch & 1)) + e;
    bool rh = false;
    if (n >= 416 && n < 416 + 1024) rh = (((n - 416) & 63) < 32);
    else if (n >= 1952 && n < 1952 + 512) rh = (((n - 1952) & 63) < 32);
    if (rh) { const int sc = (ch == 1) ? 2 : (ch == 2 ? 1 : ch); return g + 4 * sc + e; }
    return n;
}
#ifndef UP_PERM
#define UP_PERM 1
#endif
template <int DQK>
DI float dot_bf16(const float* q, const bf16_t* k) {
    float s = 0.f;
#pragma unroll
    for (int c = 0; c < DQK / 8; ++c) { const uint4 u = *(const uint4*)(k + c * 8); const unsigned w[4] = {u.x, u.y, u.z, u.w};
#pragma unroll
        for (int e = 0; e < 4; ++e) { s += q[c * 8 + 2 * e] * __uint_as_float(w[e] << 16); s += q[c * 8 + 2 * e + 1] * __uint_as_float(w[e] & 0xffff0000u); } }
    return s;
}
DI void acc_v64(float* o, float a, float p, const bf16_t* v) {
#pragma unroll
    for (int c = 0; c < 8; ++c) { const uint4 u = *(const uint4*)(v + c * 8); const unsigned w[4] = {u.x, u.y, u.z, u.w};
#pragma unroll
        for (int e = 0; e < 4; ++e) { o[c * 8 + 2 * e] = o[c * 8 + 2 * e] * a + p * __uint_as_float(w[e] << 16); o[c * 8 + 2 * e + 1] = o[c * 8 + 2 * e + 1] * a + p * __uint_as_float(w[e] & 0xffff0000u); } }
}
template <int DQK>
DI void load_q(float* q, const bf16_t* p) {
#pragma unroll
    for (int c = 0; c < DQK / 8; ++c) { const uint4 u = *(const uint4*)(p + c * 8); const unsigned w[4] = {u.x, u.y, u.z, u.w};
#pragma unroll
        for (int e = 0; e < 4; ++e) { q[c * 8 + 2 * e] = __uint_as_float(w[e] << 16); q[c * 8 + 2 * e + 1] = __uint_as_float(w[e] & 0xffff0000u); } }
}
DI unsigned sortable(float f) { const unsigned u = __float_as_uint(f); return (u & 0x80000000u) ? ~u : (u | 0x80000000u); }
namespace pg8 {
#define PG8_LAS __attribute__((address_space(3)))
typedef unsigned short bf16_t;
typedef short bf16x8 __attribute__((ext_vector_type(8)));
typedef float f32x4 __attribute__((ext_vector_type(4)));
typedef unsigned u32x4 __attribute__((ext_vector_type(4)));
constexpr int BM = 256, BK = 64, HALF = 128, HTB = HALF * BK * 2  , STAGE_BYTES = 8 * HTB, NXCD = 8, WGM = 8;

__host__ __device__ __forceinline__ int lds_byte(int r, int c) { const int st = (r >> 4) * 2 + (c >> 5), rr = r & 15, cc = c & 31, ob = rr * 64 + cc * 2; return st * 1024 + (ob ^ (((ob >> 9) & 1) << 5)); }
__host__ __device__ __forceinline__ void stage_rc(int b, int& R, int& C) { const int st = b / 1024, sb = b % 1024, swz = sb ^ (((sb >> 9) & 1) << 5); R = (st >> 1) * 16 + swz / 64; C = (st & 1) * 32 + (swz % 64) / 2; }
__host__ __device__ __forceinline__ int perm32(int rho) { const int n = rho >> 4, i = rho & 15; return 8 * (i >> 2) + 4 * n + (i & 3); }

struct Unit { int pm, pn; };
struct Gemm { const bf16_t* A; const bf16_t* Bt; int M, N, K; };

struct GridOrder {
    int nM, nN, nwg, G, c;
    __device__ void init(int nM_, int nN_, int G_, int c_) { nM = nM_; nN = nN_; nwg = nM * nN; G = G_; c = c_; }
    __device__ __forceinline__ bool next(int i, Unit& u) const {
        const long L = (long)i * G + c; if (L >= nwg) return false;
        int wgid = (int)L; { const int q = nwg / NXCD, r = nwg % NXCD, xcd = wgid % NXCD, off = wgid / NXCD; wgid = (xcd < r ? xcd * (q + 1) : r * (q + 1) + (xcd - r) * q) + off; }
        const int nig = WGM * nN, gid = wgid / nig, fm = gid * WGM, gsz = (nM - fm) < WGM ? (nM - fm) : WGM;
        u.pm = fm + ((wgid % nig) % gsz); u.pn = (wgid % nig) / gsz; return true;
    }
    __device__ __forceinline__ long arow(const Unit& u) const { return (long)u.pm * BM; }
    __device__ __forceinline__ void a_ready(const Unit&) const {}
    __device__ __forceinline__ void done(const Unit&) const {}
};
struct ConvOrder : GridOrder {
    __device__ __forceinline__ long arow(const Unit& u) const { const int b = u.pm / 33, j = u.pm % 33; return (long)b * 8192 + 254 * j - 2; }
};
template <class Epi, class Sched, bool ALIGN_EPI = false, bool SP2 = false>
__device__ __forceinline__ void gemm_phase(PG8_LAS unsigned char* lds, const Gemm g, const Sched& S, const Epi& E, const int wid) {
    int lane_ = lane_id(); asm volatile("" : "+v"(lane_));
    int wid_ = wid; asm volatile("" : "+s"(wid_));
    const int lane = lane_, tid = wid_ * 64 + lane, wr = wid_ >> 2, wc = wid_ & 3, fr = lane & 15, fq = lane >> 4;
    const int K = g.K, nt = K / BK;
    unsigned voffA[2], voffB[2];
#pragma unroll
    for (int i = 0; i < 2; ++i) { int R, C; stage_rc(tid * 16 + i * 8192, R, C); const int Rb = Epi::PERM ? ((R & ~31) + perm32(R & 31)) : R;
        voffA[i] = (unsigned)(R * K + C) * 2u; voffB[i] = (unsigned)(Rb * K + C) * 2u; }
    const size_t kstep = (size_t)(BK * 2);
    const size_t hstep = (size_t)HALF * K * 2;
    const size_t tstep = 2 * hstep;
    const unsigned ldsw = (unsigned)wid_ * 1024u;
    const int aoff = lds_byte(wr * 64 + fr, fq * 8), boff = lds_byte(wc * 32 + fr, fq * 8);
#define PG8_SA(b, h) (((b) * 2 + (h)) * HTB)
#define PG8_SB(b, h) ((4 + (b) * 2 + (h)) * HTB)
#define PG8_STAGE(bufoff, gbase, voff) do { _Pragma("unroll") for (int _i = 0; _i < 2; ++_i) \
        __builtin_amdgcn_global_load_lds((const unsigned*)((const char*)(gbase) + (voff)[_i]), (PG8_LAS unsigned*)(lds + (bufoff) + ldsw + _i * 8192), 16, 0, 0); } while (0)
#define PG8_LDA(dst, b, h) do { _Pragma("unroll") for (int m = 0; m < 4; ++m) _Pragma("unroll") for (int k = 0; k < 2; ++k) dst[m][k] = *(const PG8_LAS bf16x8*)(lds + PG8_SA(b, h) + aoff + m * 2048 + k * 1024); } while (0)
#define PG8_LDB(dst, b, h) do { _Pragma("unroll") for (int n = 0; n < 2; ++n) _Pragma("unroll") for (int k = 0; k < 2; ++k) dst[n][k] = *(const PG8_LAS bf16x8*)(lds + PG8_SB(b, h) + boff + n * 2048 + k * 1024); } while (0)
#define PG8_MMA(ai, bj, At, Bt) do { __builtin_amdgcn_s_setprio(1); _Pragma("unroll") for (int m = 0; m < 4; ++m) _Pragma("unroll") for (int n = 0; n < 2; ++n) _Pragma("unroll") for (int k = 0; k < 2; ++k) \
        acc[ai][bj][m][n] = __builtin_amdgcn_mfma_f32_16x16x32_bf16(Bt[n][k], At[m][k], acc[ai][bj][m][n], 0, 0, 0); __builtin_amdgcn_s_setprio(0); } while (0)
#define PG8_WAIT_V(n) asm volatile("s_waitcnt vmcnt(" #n ")" ::: "memory")
#define PG8_WAIT_L(n) asm volatile("s_waitcnt lgkmcnt(" #n ")" ::: "memory")
#define PG8_BAR __builtin_amdgcn_s_barrier()
#define PG8_SCHED __builtin_amdgcn_sched_barrier(0)
    Unit cur, nxt; int ui = 0;
    if (!S.next(0, cur)) return;
    f32x4 acc[2][2][4][2];
#pragma unroll
    for (int a = 0; a < 2; ++a)
#pragma unroll
        for (int b = 0; b < 2; ++b)
#pragma unroll
            for (int m = 0; m < 4; ++m)
#pragma unroll
                for (int n = 0; n < 2; ++n) acc[a][b][m][n] = (f32x4){0.f, 0.f, 0.f, 0.f};
    bf16x8 At[4][2], B0[2][2], B1[2][2];
    const char* cA = (const char*)g.A + S.arow(cur) * (long)(K * 2); const char* cB = (const char*)g.Bt + (size_t)cur.pn * tstep;
    S.a_ready(cur);
    if constexpr (SP2) {
        PG8_STAGE(PG8_SB(0, 0), cB, voffB); PG8_STAGE(PG8_SB(0, 1), cB + hstep, voffB); PG8_STAGE(PG8_SA(0, 0), cA, voffA); PG8_STAGE(PG8_SA(0, 1), cA + hstep, voffA);
        if (wr == 1) PG8_BAR;
        PG8_WAIT_V(2); PG8_BAR;
        PG8_STAGE(PG8_SB(1, 0), cB + kstep, voffB); PG8_STAGE(PG8_SA(1, 0), cA + kstep, voffA); PG8_STAGE(PG8_SB(1, 1), cB + hstep + kstep, voffB);
        PG8_WAIT_V(6); PG8_BAR;
    } else {
        PG8_STAGE(PG8_SB(0, 0), cB, voffB); PG8_STAGE(PG8_SA(0, 0), cA, voffA); PG8_STAGE(PG8_SB(0, 1), cB + hstep, voffB); PG8_STAGE(PG8_SA(0, 1), cA + hstep, voffA);
        if (wr == 1) PG8_BAR;
        PG8_WAIT_V(4); PG8_BAR;
        PG8_STAGE(PG8_SB(1, 0), cB + kstep, voffB); PG8_STAGE(PG8_SA(1, 0), cA + kstep, voffA); PG8_STAGE(PG8_SB(1, 1), cB + hstep + kstep, voffB);
        PG8_WAIT_V(6); PG8_BAR;
    }
    for (;;) {
        const bool has_next = S.next(ui + 1, nxt);
        const char* nA = has_next ? (const char*)g.A + S.arow(nxt) * (long)(K * 2) : cA; const char* nB = has_next ? (const char*)g.Bt + (size_t)nxt.pn * tstep : cB;
        for (int t = 0; t < nt; t += 2) {
            const bool last = (t == nt - 2);
            const char* a1 = cA + (size_t)(t + 1) * kstep;
            const char* a2 = last ? nA : cA + (size_t)(t + 2) * kstep; const char* b2 = last ? nB : cB + (size_t)(t + 2) * kstep;
            const char* a3 = a2 + kstep; const char* b3 = b2 + kstep;
            if (last && has_next) S.a_ready(nxt);
            if constexpr (SP2) {
            PG8_LDB(B0, 0, 0); PG8_LDB(B1, 0, 1); PG8_SCHED; PG8_LDA(At, 0, 0); PG8_STAGE(PG8_SA(1, 1), a1 + hstep, voffA);
            PG8_WAIT_V(8); PG8_WAIT_L(0); PG8_BAR; PG8_MMA(0, 0, At, B0); PG8_MMA(0, 1, At, B1); PG8_BAR; PG8_SCHED;
            PG8_LDA(At, 0, 1); PG8_STAGE(PG8_SB(0, 0), b2, voffB); PG8_STAGE(PG8_SB(0, 1), b2 + hstep, voffB); PG8_STAGE(PG8_SA(0, 0), a2, voffA);
            PG8_WAIT_V(8); PG8_WAIT_L(0); PG8_BAR; PG8_MMA(1, 0, At, B0); PG8_MMA(1, 1, At, B1); PG8_BAR; PG8_SCHED;
            PG8_LDB(B0, 1, 0); PG8_LDB(B1, 1, 1); PG8_SCHED; PG8_LDA(At, 1, 0); PG8_STAGE(PG8_SA(0, 1), a2 + hstep, voffA);
            PG8_WAIT_V(8); PG8_WAIT_L(0); PG8_BAR; PG8_MMA(0, 0, At, B0); PG8_MMA(0, 1, At, B1); PG8_BAR; PG8_SCHED;
            PG8_LDA(At, 1, 1); PG8_STAGE(PG8_SB(1, 0), b3, voffB); PG8_STAGE(PG8_SB(1, 1), b3 + hstep, voffB); PG8_STAGE(PG8_SA(1, 0), a3, voffA);
            PG8_WAIT_V(8); PG8_WAIT_L(0); PG8_BAR; PG8_MMA(1, 0, At, B0); PG8_MMA(1, 1, At, B1); PG8_BAR; PG8_SCHED;
            } else {
            PG8_LDB(B0, 0, 0); PG8_SCHED; PG8_LDA(At, 0, 0); PG8_STAGE(PG8_SA(1, 1), a1 + hstep, voffA);
            PG8_WAIT_L(8); PG8_BAR; PG8_WAIT_L(0); PG8_MMA(0, 0, At, B0); PG8_BAR; PG8_SCHED;
            PG8_LDB(B1, 0, 1); PG8_STAGE(PG8_SB(0, 0), b2, voffB);
            PG8_BAR; PG8_WAIT_L(0); PG8_MMA(0, 1, At, B1); PG8_BAR;
            PG8_LDA(At, 0, 1); PG8_STAGE(PG8_SA(0, 0), a2, voffA);
            PG8_BAR; PG8_WAIT_L(0); PG8_MMA(1, 0, At, B0); PG8_BAR; PG8_SCHED;
            PG8_STAGE(PG8_SB(0, 1), b2 + hstep, voffB);
            PG8_WAIT_V(6); PG8_BAR; PG8_MMA(1, 1, At, B1); PG8_BAR;
            PG8_LDB(B0, 1, 0); PG8_SCHED; PG8_LDA(At, 1, 0); PG8_STAGE(PG8_SA(0, 1), a2 + hstep, voffA);
            PG8_WAIT_L(8); PG8_BAR; PG8_WAIT_L(0); PG8_MMA(0, 0, At, B0); PG8_BAR; PG8_SCHED;
            PG8_LDB(B1, 1, 1); PG8_STAGE(PG8_SB(1, 0), b3, voffB);
            PG8_BAR; PG8_WAIT_L(0); PG8_MMA(0, 1, At, B1); PG8_BAR;
            PG8_LDA(At, 1, 1); PG8_STAGE(PG8_SA(1, 0), a3, voffA);
            PG8_BAR; PG8_WAIT_L(0); PG8_MMA(1, 0, At, B0); PG8_BAR; PG8_SCHED;
            PG8_STAGE(PG8_SB(1, 1), b3 + hstep, voffB);
            PG8_WAIT_V(6); PG8_BAR; PG8_MMA(1, 1, At, B1); PG8_BAR;
            }
        }
        if constexpr (ALIGN_EPI) { if (wr == 0) PG8_BAR; }
        if constexpr (!Epi::AFTER_DRAIN) { E(acc, cur, wr, wc, fr, fq); S.done(cur); }
        if (!has_next) break;
#pragma unroll
        for (int a = 0; a < 2; ++a)
#pragma unroll
            for (int b = 0; b < 2; ++b)
#pragma unroll
                for (int m = 0; m < 4; ++m)
#pragma unroll
                    for (int n = 0; n < 2; ++n) acc[a][b][m][n] = (f32x4){0.f, 0.f, 0.f, 0.f};
        cur = nxt; cA = nA; cB = nB; ++ui;
        if constexpr (ALIGN_EPI) { if (wr == 1) PG8_BAR; }
    }
    PG8_WAIT_V(0);
    if constexpr (!ALIGN_EPI) { if (wr == 0) PG8_BAR; }
    PG8_BAR;
    if constexpr (Epi::AFTER_DRAIN) { E.fused(acc, cur, wr, wc, fr, fq, lds, wid, lane); S.done(cur); }
#undef PG8_SA
#undef PG8_SB
#undef PG8_STAGE
#undef PG8_LDA
#undef PG8_LDB
#undef PG8_MMA
#undef PG8_WAIT_V
#undef PG8_WAIT_L
#undef PG8_BAR
#undef PG8_SCHED
}
}
using pg8::Unit;

DI void rope4(const f32x4 x1, const f32x4 x2, const float* cs, const float* sn, f32x4& o1, f32x4& o2) {
    const f32x4 c = *(const f32x4*)cs, s = *(const f32x4*)sn;
    o1 = x1 * c - x2 * s; o2 = x2 * c + x1 * s;
}

DI void rope4l(const f32x4 x1, const f32x4 x2, const LAS float* cs, const LAS float* sn, f32x4& o1, f32x4& o2) {
    const f32x4 c = *(const LAS f32x4*)cs, s = *(const LAS f32x4*)sn;
    o1 = x1 * c - x2 * s; o2 = x2 * c + x1 * s;
}
struct EpiInproj {
    static constexpr bool PERM = true, AFTER_DRAIN = false;
    Bufs B; LAS float* rb;
    DI void operator()(const f32x4 (&acc)[2][2][4][2], const Unit& u, int wr, int wc, int fr, int fq) const {
        { int l_ = lane_id(); asm volatile("" : "+v"(l_)); fr = l_ & 15; fq = l_ >> 4; }
        const int rowbase = u.pm * 256 + wr * 64 + fr;
        const bool hrope = u.pn * 256 + 256 > 416 && u.pn * 256 < 2464;
        if (hrope) {
            const int tid = (wr * 4 + wc) * 64 + fr + 16 * fq;
            if (tid < 256) { const int t = (u.pm * 256 + tid) & (S - 1);
                const f32x4 c0 = *(const f32x4*)(B.cosH() + t * 8), c1 = *(const f32x4*)(B.cosH() + t * 8 + 4), s0 = *(const f32x4*)(B.sinH() + t * 8), s1 = *(const f32x4*)(B.sinH() + t * 8 + 4);
                LAS f32x4* d = (LAS f32x4*)(rb + tid * 16); d[0] = c0; d[1] = c1; d[2] = s0; d[3] = s1; }
            asm volatile("s_waitcnt lgkmcnt(0)" ::: "memory");
            __builtin_amdgcn_s_barrier();
            asm volatile("" ::: "memory");
        }
        float rs[2][4];
#pragma unroll
        for (int ai = 0; ai < 2; ++ai)
#pragma unroll
            for (int m = 0; m < 4; ++m) rs[ai][m] = rs_of(B.RSP(), (size_t)(rowbase + ai * 128 + m * 16));
#pragma unroll
        for (int bj = 0; bj < 2; ++bj) {
            const int gcol = u.pn * 256 + bj * 128 + wc * 32;
            if (gcol >= 3040) continue;
#pragma unroll
            for (int ai = 0; ai < 2; ++ai)
#pragma unroll
                for (int m = 0; m < 4; ++m) {
                    const size_t row = (size_t)(rowbase + ai * 128 + m * 16); const int t = (int)(row & (S - 1));
                    const float r = rs[ai][m];
                    f32x4 v0 = acc[ai][bj][m][0] * r, v1 = acc[ai][bj][m][1] * r;
                    if (gcol < 384) {
                        *(u32x4*)(B.CQKV() + row * 384 + gcol + 8 * fq) = pk8(v0, v1);
                        float ss = (v0[0] * v0[0] + v0[1] * v0[1]) + (v0[2] * v0[2] + v0[3] * v0[3]) + (v1[0] * v1[0] + v1[1] * v1[1]) + (v1[2] * v1[2] + v1[3] * v1[3]);
                        ss += shfl_xor_l(ss, 16, fr + 16 * fq); ss += shfl_xor_l(ss, 32, fr + 16 * fq);
                        if (fq == 0) { if (gcol < 256) B.RQP()[row * 8 + (gcol >> 5)] = ss; else B.RKVP()[row * 4 + ((gcol - 256) >> 5)] = ss; }
                    } else if (gcol == 384) {
                        f32x4 o1, o2; rope4(v0, v1, B.cosA() + t * 16 + 4 * fq, B.sinA() + t * 16 + 4 * fq, o1, o2);
                        const u32x2 p1 = pk4(o1), p2 = pk4(o2);
#pragma unroll
                        for (int h = 0; h < 4; ++h) { *(u32x2*)(B.KM() + (row * 4 + h) * 96 + 64 + 4 * fq) = p1; *(u32x2*)(B.KM() + (row * 4 + h) * 96 + 80 + 4 * fq) = p2; }
                    } else if (gcol < 2720) {
                        const bool dil = gcol < 1952; const int c = dil ? gcol - 416 : gcol - 1952; const int hw = dil ? 512 : 256;
                        const int which = c / hw, hd = (c % hw) >> 6, half = (c >> 5) & 1;
                        bf16_t* dst = dil ? (which == 0 ? B.DQ() : (which == 1 ? B.DK() : B.DV())) : (which == 0 ? B.SQ() : (which == 1 ? B.SK() : B.SV()));
                        bf16_t* p = dst + (row * (dil ? 8 : 4) + hd) * 64 + half * 32;
                        const float qs = which == 0 ? QSCALE_64 : 1.f;
                        if (which < 2 && half == 0 && fq < 2) {
                            const LAS float* rr = rb + (wr * 64 + fr + ai * 128 + m * 16) * 16 + 4 * fq;
                            f32x4 o1, o2; rope4l(v0, v1, rr, rr + 8, o1, o2);
                            *(u32x2*)(p + 4 * fq) = pk4(o1 * qs); *(u32x2*)(p + 8 + 4 * fq) = pk4(o2 * qs);
                        } else *(u32x4*)(p + 8 * fq) = pk8(v0 * qs, v1 * qs);
                    } else if (gcol < 3008) {
                        if (fq == 0) { f32x4 o1, o2; rope4(v0, v1, B.cosI() + t * 4, B.sinI() + t * 4, o1, o2); v0 = o1; v1 = o2; }
                        bf16_t* p = gcol < 2976 ? B.QI() + row * 256 + (gcol - 2720) : B.KI() + row * 32;
                        *(u32x4*)(p + 8 * fq) = pk8(v0, v1);
                    } else {
                        if (fq == 0) { *(f32x4*)(B.WI() + row * 8) = v0 * 0.03125f; *(f32x4*)(B.WI() + row * 8 + 4) = v1 * 0.03125f; }
                    }
                }
        }
    }
};

struct EpiLat {
    static constexpr bool PERM = true, AFTER_DRAIN = false;
    Bufs B; LAS float* rl;
    DI void operator()(const f32x4 (&acc)[2][2][4][2], const Unit& u, int wr, int wc, int fr, int fq) const {
        { int l_ = lane_id(); asm volatile("" : "+v"(l_)); fr = l_ & 15; fq = l_ >> 4; }
        const int rowbase = u.pm * 256 + wr * 64 + fr;
        { const int tid = (wr * 4 + wc) * 64 + fr + 16 * fq;
          if (tid < 256) { const size_t row = (size_t)u.pm * 256 + tid;
            const f32x4 a = *(const f32x4*)(B.RQP() + row * 8), b = *(const f32x4*)(B.RQP() + row * 8 + 4), c = *(const f32x4*)(B.RKVP() + row * 4);
            rl[2 * tid] = rsqrtf((((a[0] + a[1]) + (a[2] + a[3])) + ((b[0] + b[1]) + (b[2] + b[3]))) * (1.f / 256.f) + EPS) * QSCALE_MLA;
            rl[2 * tid + 1] = rsqrtf(((c[0] + c[1]) + (c[2] + c[3])) * (1.f / 128.f) + EPS); }
          asm volatile("s_waitcnt lgkmcnt(0)" ::: "memory");
          __builtin_amdgcn_s_barrier();
          asm volatile("" ::: "memory"); }
#pragma unroll
        for (int bj = 0; bj < 2; ++bj) {
            const int g32 = (u.pn * 256 + bj * 128 + wc * 32) >> 5;
            if (g32 >= 28) continue;
#pragma unroll
            for (int ai = 0; ai < 2; ++ai)
#pragma unroll
                for (int m = 0; m < 4; ++m) {
                    const size_t row = (size_t)(rowbase + ai * 128 + m * 16); const int t = (int)(row & (S - 1));
                    if (g32 < 12) {
                        const float r = rl[2 * (wr * 64 + fr + ai * 128 + m * 16)];
                        const f32x4 v0 = acc[ai][bj][m][0] * r, v1 = acc[ai][bj][m][1] * r;
                        const int h = g32 / 3, part = g32 % 3; bf16_t* p = B.QM() + (row * 4 + h) * 96;
                        if (part < 2) *(u32x4*)(p + 32 * part + 8 * fq) = pk8(v0, v1);
                        else { f32x4 o1, o2; rope4(v0, v1, B.cosA() + t * 16 + 4 * fq, B.sinA() + t * 16 + 4 * fq, o1, o2); *(u32x2*)(p + 64 + 4 * fq) = pk4(o1); *(u32x2*)(p + 80 + 4 * fq) = pk4(o2); }
                    } else {
                        const float r = rl[2 * (wr * 64 + fr + ai * 128 + m * 16) + 1];
                        const f32x4 v0 = acc[ai][bj][m][0] * r, v1 = acc[ai][bj][m][1] * r;
                        const int gk = g32 - 12, h = gk >> 2, part = gk & 3;
                        if (part < 2) *(u32x4*)(B.KM() + (row * 4 + h) * 96 + 32 * part + 8 * fq) = pk8(v0, v1);
                        else *(u32x4*)(B.VM() + (row * 4 + h) * 64 + 32 * (part - 2) + 8 * fq) = pk8(v0, v1);
                    }
                }
        }
    }
};

template <bool DRY> struct EpiResidT {
    static constexpr bool PERM = true, AFTER_DRAIN = false;
    Bufs B; LAS float* red;
    DI void operator()(const f32x4 (&acc)[2][2][4][2], const Unit& u, int wr, int wc, int fr, int fq) const {
        { int l_ = lane_id(); asm volatile("" : "+v"(l_)); fr = l_ & 15; fq = l_ >> 4; }
        const int rowbase = u.pm * 256 + wr * 64 + fr;
#pragma unroll
        for (int ai = 0; ai < 2; ++ai)
#pragma unroll
            for (int m = 0; m < 4; ++m) {
                const size_t row = (size_t)(rowbase + ai * 128 + m * 16);
                float ss = 0.f;
#pragma unroll
                for (int bj = 0; bj < 2; ++bj) {
                    const int col0 = u.pn * 256 + bj * 128 + wc * 32 + 8 * fq;
                    float* xp = B.X() + row * D + col0;
                    f32x4 x0 = *(const f32x4*)xp, x1 = *(const f32x4*)(xp + 4);
                    x0 += acc[ai][bj][m][0]; x1 += acc[ai][bj][m][1];
                    if (DRY) { float* dp = (float*)(B.ws + OFF_DUMP) + (fr + 16 * fq) * 8; *(f32x4*)dp = x0; *(f32x4*)(dp + 4) = x1; *(u32x4*)(dp + 512) = pk8(x0, x1); }
                    else { *(f32x4*)xp = x0; *(f32x4*)(xp + 4) = x1;
                    *(u32x4*)(B.XB() + row * D + col0) = pk8(x0, x1); }
                    ss += ((x0[0] * x0[0] + x0[1] * x0[1]) + (x0[2] * x0[2] + x0[3] * x0[3])) + ((x1[0] * x1[0] + x1[1] * x1[1]) + (x1[2] * x1[2] + x1[3] * x1[3]));
                }
                ss += shfl_xor_l(ss, 16, fr + 16 * fq); ss += shfl_xor_l(ss, 32, fr + 16 * fq);
                if (fq == 0) red[wc * 256 + ai * 128 + wr * 64 + m * 16 + fr] = ss;
            }
        asm volatile("s_waitcnt lgkmcnt(0)" ::: "memory");
        __builtin_amdgcn_s_barrier();
        asm volatile("" ::: "memory");
        { const int wv = wr * 4 + wc, l = fr + 16 * fq;
          if (l < 32) { const int r = wv * 32 + l; const float t = (red[r] + red[256 + r]) + (red[512 + r] + red[768 + r]); if (DRY) ((float*)(B.ws + OFF_DUMP))[2048 + l] = t; else B.RSP()[((size_t)u.pm * 256 + r) * 4 + u.pn] = t; } }
    }
};
typedef EpiResidT<false> EpiResid;

#ifndef USE_DPP
#define USE_DPP 1
#endif
template <int N> DI float rot16(float v, int lane) {
#if USE_DPP
    return __builtin_bit_cast(float, __builtin_amdgcn_update_dpp(0, __builtin_bit_cast(int, v), 0x120 + N, 0xf, 0xf, false));
#else
    return __shfl(v, (lane & 48) | ((lane - N) & 15), 64);
#endif
}
template <int N> DI f32x4 rot16v(f32x4 v, int lane) { f32x4 r; r[0] = rot16<N>(v[0], lane); r[1] = rot16<N>(v[1], lane); r[2] = rot16<N>(v[2], lane); r[3] = rot16<N>(v[3], lane); return r; }
DI f32x4 sel4(bool c, f32x4 a, f32x4 b) { f32x4 r; r[0] = c ? a[0] : b[0]; r[1] = c ? a[1] : b[1]; r[2] = c ? a[2] : b[2]; r[3] = c ? a[3] : b[3]; return r; }

struct EpiConvAct {
    static constexpr bool PERM = true, AFTER_DRAIN = false;
    Bufs B; const float* cw; const float* cb; LAS float* halo;
    DI void operator()(const f32x4 (&acc_)[2][2][4][2], const Unit& u, int wr, int wc, int fr, int fq) const {
        { int l_ = lane_id(); asm volatile("" : "+v"(l_)); fr = l_ & 15; fq = l_ >> 4; }
        f32x4 (&us)[2][2][4][2] = const_cast<f32x4 (&)[2][2][4][2]>(acc_);
        const int lane = fr + 16 * fq;
        const int b = u.pm >> 5, j = u.pm & 31;
        const long arow = (long)u.pm * 256;
        LAS float* rsb = halo + 2048;
        LAS float* cwl = halo + 2048 + 256;
        { const int tid = (wr * 4 + wc) * 64 + lane; if (tid < 256) { rsb[tid] = rs_of(B.RSP(), (size_t)(arow + tid));
            const int bjc = tid >> 7, cc = tid & 127; const float* cwp = cw + bjc * DFF + u.pn * 128 + cc;
            cwl[0 * 256 + tid] = cwp[0]; cwl[1 * 256 + tid] = cwp[NUP]; cwl[2 * 256 + tid] = cwp[2 * NUP]; cwl[3 * 256 + tid] = cb[bjc * DFF + u.pn * 128 + cc]; } }
        asm volatile("s_waitcnt lgkmcnt(0)" ::: "memory");
        __builtin_amdgcn_s_barrier();
        asm volatile("" ::: "memory");
#pragma unroll
        for (int ai = 0; ai < 2; ++ai)
#pragma unroll
            for (int m = 0; m < 4; ++m) {
                const float r = rsb[ai * 128 + wr * 64 + m * 16 + fr];
#pragma unroll
                for (int bj = 0; bj < 2; ++bj) { us[ai][bj][m][0] = us[ai][bj][m][0] * r; us[ai][bj][m][1] = us[ai][bj][m][1] * r; }
            }
        { float* bnd = (float*)(B.ws + OFF_BND) + ((size_t)(u.pm * 22 + u.pn) * 4) * 256 + wc * 32 + 8 * fq;
          if (wr == 0 && fr < 2) {
#pragma unroll
              for (int bj = 0; bj < 2; ++bj)
#pragma unroll
                  for (int n = 0; n < 2; ++n) *(f32x4*)(bnd + fr * 256 + bj * 128 + 4 * n) = us[0][bj][0][n]; }
          if (wr == 1 && fr >= 14) {
#pragma unroll
              for (int bj = 0; bj < 2; ++bj)
#pragma unroll
                  for (int n = 0; n < 2; ++n) *(f32x4*)(bnd + (fr - 12) * 256 + bj * 128 + 4 * n) = us[1][bj][3][n]; } }
        if (fr >= 14) {
#pragma unroll
            for (int ai = 0; ai < 2; ++ai)
#pragma unroll
                for (int bj = 0; bj < 2; ++bj)
#pragma unroll
                    for (int n = 0; n < 2; ++n) {
                        const int g = 2 * ai + wr;
                        *(LAS f32x4*)(halo + ((((((g * 2 + bj) * 4 + wc) * 2 + (fr - 14)) * 4 + fq) * 2 + n) * 4)) = us[ai][bj][3][n];
                    }
        }
        asm volatile("s_waitcnt lgkmcnt(0)" ::: "memory");
        __builtin_amdgcn_s_barrier();
        asm volatile("" ::: "memory");
        float chain = 0.f;
#pragma unroll
        for (int n = 0; n < 2; ++n) {
#pragma unroll
            for (int bj = 0; bj < 2; ++bj) {
#pragma unroll
                for (int ai = 0; ai < 2; ++ai) {
                    int fro = fr, fqo = fq;
                    asm volatile("" : "+v"(fro), "+v"(fqo), "+v"(chain) :: "memory");
                    const int col = u.pn * 128 + wc * 32 + 8 * fqo + 4 * n;
                    const LAS float* cwq = cwl + bj * 128 + wc * 32 + 8 * fqo + 4 * n;
                    const f32x4 w0 = *(const LAS f32x4*)(cwq), w1 = *(const LAS f32x4*)(cwq + 256), w2 = *(const LAS f32x4*)(cwq + 512), bb = *(const LAS f32x4*)(cwq + 768);
                    const int g = 2 * ai + wr, gp = g > 0 ? g - 1 : 0;
                    const int hoff = (((((gp * 2 + bj) * 4 + wc) * 2 + 0) * 4 + fqo) * 2 + n) * 4;
                    const f32x4 h62 = *(const LAS f32x4*)(halo + hoff);
                    const f32x4 h63 = *(const LAS f32x4*)(halo + hoff + 32);
                    f32x4 r1p = h63, r2p = sel4(fro == 0, h62, h63);
                    const int lr0 = ai * 128 + wr * 64 + fro; const int t0 = 256 * j + lr0;
                    bf16_t* const orow = B.ACT() + ((size_t)b * S + t0) * DFF + col;
#pragma unroll
                    for (int m = 0; m < 4; ++m) {
                        const int lr = lr0 + m * 16, t = t0 + m * 16;
                        f32x4 cur;
                        { float c0 = us[ai][bj][m][n][0], c1 = us[ai][bj][m][n][1], c2 = us[ai][bj][m][n][2], c3 = us[ai][bj][m][n][3];
                          asm volatile("" : "+v"(c0), "+v"(c1), "+v"(c2), "+v"(c3), "+v"(chain) :: "memory");
                          cur[0] = c0; cur[1] = c1; cur[2] = c2; cur[3] = c3; }
                        const f32x4 r1 = rot16v<1>(cur, lane), r2 = rot16v<2>(cur, lane);
                        f32x4 p1 = sel4(fro >= 1, r1, r1p), p2 = sel4(fro >= 2, r2, r2p);
                        r1p = r1; r2p = r2;
                        const f32x4 y = bb + w2 * cur + w1 * p1 + w0 * p2;
                        chain = y[3];
                        if (bj == 0) {
                            f32x4 a;
#pragma unroll
                            for (int e = 0; e < 4; ++e) a[e] = y[e] * __builtin_amdgcn_rcpf(1.f + __builtin_amdgcn_exp2f(-LOG2E * y[e]));
                            us[ai][0][m][n] = a;
                        } else {
                            bf16_t* dst = lr >= 2 ? orow + (size_t)m * 16 * DFF : (bf16_t*)(B.ws + OFF_DUMP) + lane * 4;
                            *(u32x2*)dst = pk4(us[ai][0][m][n] * y);
                        }
                    }
                }
            }
        }
    }
};

DI void conv_fixup(const Bufs& B, const float* cw, const float* cb, int pm, int tid) {
    const float* bnd = (const float*)(B.ws + OFF_BND);
    const bool top = (pm & 31) == 0;
    constexpr int NQ = 6;
    { const int c0 = tid;
        float og[NQ][4], ou[NQ][4], wg[NQ][3], wu[NQ][3], bg[NQ], bu[NQ];
#pragma unroll
        for (int q = 0; q < NQ; ++q) { const int cq = c0 + 512 * q; const int c = cq < DFF ? cq : tid; const int pn = c >> 7, cc = c & 127;
            const float* own = bnd + ((size_t)(pm * 22 + pn) * 4) * 256 + cc; const float* prv = top ? own : own - (size_t)22 * 4 * 256;
            og[q][0] = prv[2 * 256]; og[q][1] = prv[3 * 256]; og[q][2] = own[0]; og[q][3] = own[256];
            ou[q][0] = prv[2 * 256 + 128]; ou[q][1] = prv[3 * 256 + 128]; ou[q][2] = own[128]; ou[q][3] = own[256 + 128];
#pragma unroll
            for (int k = 0; k < 3; ++k) { wg[q][k] = cw[k * NUP + c]; wu[q][k] = cw[k * NUP + DFF + c]; }
            bg[q] = cb[c]; bu[q] = cb[DFF + c]; }
#pragma unroll
        for (int q = 0; q < NQ; ++q) { const int cq = c0 + 512 * q; if (cq < DFF) {
            if (top) { og[q][0] = 0.f; og[q][1] = 0.f; ou[q][0] = 0.f; ou[q][1] = 0.f; }
#pragma unroll
            for (int r = 0; r < 2; ++r) {
                const float yg = bg[q] + wg[q][2] * og[q][r + 2] + wg[q][1] * og[q][r + 1] + wg[q][0] * og[q][r];
                const float yu = bu[q] + wu[q][2] * ou[q][r + 2] + wu[q][1] * ou[q][r + 1] + wu[q][0] * ou[q][r];
                const float a = yg * __builtin_amdgcn_rcpf(1.f + __builtin_amdgcn_exp2f(-LOG2E * yg));
                B.ACT()[((size_t)pm * 256 + r) * DFF + cq] = f2bf(a * yu); } } }
    }
}
#define XB_TMO      128
#define XB_XCNT(j)  (256  + 64 * (j))
#define XB_XSUB(j)  (1280 + 64 * (j))
#define XB_XGEN(j)  (2304 + 64 * (j))
#define XB_TOP      3328
#define XB_TOPGEN   3392
#define XCD_BAR_WORDS 3456
#define XB_SPIN_CAP (1u << 24)

__device__ __forceinline__ unsigned xb_ld(unsigned* p)              { return __hip_atomic_load(p, __ATOMIC_RELAXED, __HIP_MEMORY_SCOPE_AGENT); }
__device__ __forceinline__ unsigned xb_add(unsigned* p, unsigned v) { return __hip_atomic_fetch_add(p, v, __ATOMIC_RELAXED, __HIP_MEMORY_SCOPE_AGENT); }
__device__ __forceinline__ unsigned xb_xcc_id() { return (unsigned)__builtin_amdgcn_s_getreg((3 << 11) | 20) & 0xFu; }
#define XB_SPIN(cond, bar) do { unsigned _sp = 0; while (cond) { __builtin_amdgcn_s_sleep(1); \
    if ((++_sp & 255u) == 0u) { if (xb_ld(&(bar)[XB_TMO])) break; if (_sp > XB_SPIN_CAP) { atomicAdd(&(bar)[XB_TMO], 1u); break; } } } } while (0)

struct XcdBarrier { unsigned* bar; unsigned x; volatile LAS unsigned* st; };

__device__ __forceinline__ XcdBarrier xcd_barrier_post(unsigned* bar, volatile LAS unsigned* st, bool is_t0) {
    XcdBarrier b; b.bar = bar; b.x = xb_xcc_id(); b.st = st;
    if (is_t0) (void)xb_add(&bar[XB_XCNT(b.x)], 1u);
    return b;
}
__device__ __forceinline__ void xcd_barrier_complete(unsigned* bar, unsigned x, unsigned& nloc, unsigned& nx) {
    const unsigned G = gridDim.x * gridDim.y * gridDim.z;
    unsigned sum, cnt, mine, sp = 0u;
    for (;;) {
        sum = 0u; cnt = 0u; mine = 0u;
#pragma unroll
        for (unsigned j = 0; j < 16; ++j) { const unsigned c = xb_ld(&bar[XB_XCNT(j)]); sum += c; cnt += (c > 0u) ? 1u : 0u; mine = (j == x) ? c : mine; }
        if (sum == G) break;
        __builtin_amdgcn_s_sleep(1);
        if ((++sp & 255u) == 0u) { if (xb_ld(&bar[XB_TMO])) break; if (sp > XB_SPIN_CAP) { atomicAdd(&bar[XB_TMO], 1u); break; } }
    }
    nloc = mine > 0u ? mine : 1u; nx = cnt > 0u ? cnt : 1u;
}
__device__ __forceinline__ void xcd_barrier(const XcdBarrier& b, bool is_t0) {
    asm volatile("s_waitcnt vmcnt(0)" ::: "memory");
    __syncthreads();
    if (is_t0) {
        unsigned* bar = b.bar;
        __builtin_amdgcn_s_waitcnt(0);
        unsigned nloc = b.st[0], nx = b.st[1];
        if (nloc == 0u) { xcd_barrier_complete(bar, b.x, nloc, nx); b.st[0] = nloc; b.st[1] = nx; }
        const unsigned old = xb_add(&bar[XB_XSUB(b.x)], 1u);
        const unsigned gen = old / nloc;
        if (old + 1u == (gen + 1u) * nloc) {
            __builtin_amdgcn_fence(__ATOMIC_RELEASE, "agent");
            asm volatile("s_waitcnt vmcnt(0)" ::: "memory");
            const unsigned og = xb_add(&bar[XB_TOP], 1u);
            const unsigned tg = og / nx;
            if (og + 1u == (tg + 1u) * nx) xb_add(&bar[XB_TOPGEN], 1u);
            else XB_SPIN(xb_ld(&bar[XB_TOPGEN]) == tg, bar);
            __builtin_amdgcn_fence(__ATOMIC_ACQUIRE, "agent");
            xb_add(&bar[XB_XGEN(b.x)], 1u);
            asm volatile("s_waitcnt vmcnt(0)" ::: "memory");
        } else {
            XB_SPIN(xb_ld(&bar[XB_XGEN(b.x)]) == gen, bar);
            __builtin_amdgcn_fence(__ATOMIC_ACQUIRE, "agent");
            asm volatile("s_waitcnt vmcnt(0)" ::: "memory");
        }
    }
    __syncthreads();
}

constexpr int NWAVES = 8, NTHR = NWAVES * 64;
constexpr int LDS_BYTES = 163840;
constexpr int LDS_STAGE = 0;
constexpr int LDS_HALO = 131072;
constexpr int LDS_MISC = LDS_BYTES - 64;

#ifndef RESC_THR
#define RESC_THR 8.0f
#endif
typedef short v4i16_t __attribute__((ext_vector_type(4)));
#define MFMA32(a, b, c) __builtin_amdgcn_mfma_f32_32x32x16_bf16((a), (b), (c), 0, 0, 0)
DI s16x4 vtr(const LAS char* p) { return __builtin_bit_cast(s16x4, __builtin_amdgcn_ds_read_tr16_b64_v4i16((LAS v4i16_t*)p)); }
DI int keyperm(int i) { return (i & 0x13) | ((i & 4) << 1) | ((i & 8) >> 1); }
constexpr int VT_STRIDE = 192, VT_BYTES = 32 * VT_STRIDE;
constexpr float NEG_BIG = -1e30f;

struct AttnState { f32x16 o0, o1; float m, l; };
DI void attn_init(AttnState& st) {
#pragma unroll
    for (int r = 0; r < 16; ++r) { st.o0[r] = 0.f; st.o1[r] = 0.f; }
    st.m = NEG_BIG; st.l = 0.f;
}
template <int NKS> struct KVTile { u32x4 kc[NKS]; u32x4 vc[4]; };
template <int NKS> DI int k_lds_off(int row, int chunk) { return NKS == 4 ? row * 128 + ((chunk ^ (row & 7)) << 4) : row * 208 + chunk * 16; }
template <int NKS> constexpr int k_lds_bytes() { return NKS == 4 ? 4096 : 6656; }
typedef __amdgpu_buffer_rsrc_t rsrc_t;
DI rsrc_t make_rsrc(const void* base) { return __builtin_amdgcn_make_buffer_rsrc((void*)base, 0, 0x7fffffff, 0x00020000); }
template <int NKS> DI void kv_load(KVTile<NKS>& T, rsrc_t kr, const unsigned (&ko)[NKS], int ksoff, rsrc_t vr, const unsigned (&vo)[4], int vsoff) {
#pragma unroll
    for (int j = 0; j < NKS; ++j) T.kc[j] = __builtin_amdgcn_raw_buffer_load_b128(kr, ko[j], ksoff, 0);
#pragma unroll
    for (int j = 0; j < 4; ++j) T.vc[j] = __builtin_amdgcn_raw_buffer_load_b128(vr, vo[j], vsoff, 0);
}
template <int NKS, class MaskF>
DI void attn_core(AttnState& st, const bf16x8 (&qf)[NKS], const LAS char* kl, const LAS char* vl, int rowbase, int lane, const MaskF& mask) {
    const int hi = lane >> 5, n = lane & 31;
    f32x16 sa;
#pragma unroll
    for (int r = 0; r < 16; ++r) { const int kk = 16 * (r >> 3) + 8 * hi + (r & 7); sa[r] = mask(n, kk, r) ? 0.f : -1e30f; }
    const int krow = rowbase + keyperm(n);
#pragma unroll
    for (int s = 0; s < NKS; ++s) { const bf16x8 kf = *(const LAS bf16x8*)(kl + k_lds_off<NKS>(krow, 2 * s + hi)); sa = MFMA32(kf, qf[s], sa); }
    float tmax;
    asm volatile("s_nop 7\n\ts_nop 7\n\ts_nop 1\n\tv_max3_f32 %0, %1, %2, %3" : "=v"(tmax) : "v"(sa[0]), "v"(sa[1]), "v"(-1e20f));
#pragma unroll
    for (int r = 2; r < 16; r += 2) asm("v_max3_f32 %0, %1, %2, %3" : "=v"(tmax) : "v"(tmax), "v"(sa[r]), "v"(sa[r + 1]));
    tmax = fmaxf(tmax, shfl_xor_l(tmax, 32, lane));
    float mn = st.m;
    if (__builtin_amdgcn_ballot_w64(tmax > st.m + RESC_THR) != 0ull) {
        mn = fmaxf(st.m, tmax);
        const float alpha = __builtin_amdgcn_exp2f(st.m - mn);
        st.l *= alpha; st.m = mn;
#pragma unroll
        for (int r = 0; r < 16; ++r) { st.o0[r] *= alpha; st.o1[r] *= alpha; }
    }
    float rsum = 0.f;
#pragma unroll
    for (int r = 0; r < 16; ++r) { const float p = __builtin_amdgcn_exp2f(sa[r] - mn); sa[r] = p; rsum += p; }
    st.l += rsum;
    bf16x8 pf[2];
#pragma unroll
    for (int s = 0; s < 2; ++s) { u32x4 w; w.x = pk2(sa[8 * s], sa[8 * s + 1]); w.y = pk2(sa[8 * s + 2], sa[8 * s + 3]); w.z = pk2(sa[8 * s + 4], sa[8 * s + 5]); w.w = pk2(sa[8 * s + 6], sa[8 * s + 7]); pf[s] = __builtin_bit_cast(bf16x8, w); }
    const int g = lane >> 4, i16 = lane & 15, q = i16 >> 2, p = i16 & 3;
    const LAS char* vr = vl + (rowbase + 8 * (g >> 1) + q) * VT_STRIDE + (16 * (g & 1) + 4 * p) * 2;
#pragma unroll
    for (int db = 0; db < 2; ++db)
#pragma unroll
        for (int s = 0; s < 2; ++s) {
            const s16x4 lo = vtr(vr + (16 * s) * VT_STRIDE + 64 * db), hi4 = vtr(vr + (16 * s + 4) * VT_STRIDE + 64 * db);
            const bf16x8 vf = __builtin_shufflevector(lo, hi4, 0, 1, 2, 3, 4, 5, 6, 7);
            if (db == 0) st.o0 = MFMA32(vf, pf[s], st.o0); else st.o1 = MFMA32(vf, pf[s], st.o1);
        }
}
constexpr float MASKED_S = -1e30f, M_FLOOR = -1e20f;
DI float max3f(float a, float b, float c) { float r; asm("v_max3_f32 %0, %1, %2, %3" : "=v"(r) : "v"(a), "v"(b), "v"(c)); return r; }
template <int NKS, bool ANYMASK, class MaskF>
DI void qk64(f32x16& sa, f32x16& sb, const bf16x8 (&qf)[NKS], const LAS char* kl, int lane, const MaskF& mask) {
    const int hi = lane >> 5, n = lane & 31;
#pragma unroll
    for (int r = 0; r < 16; ++r) {
        if (ANYMASK) { const int kk = 16 * (r >> 3) + 8 * hi + (r & 7); sa[r] = mask(0, n, kk, r) ? 0.f : MASKED_S; sb[r] = mask(1, n, kk, r) ? 0.f : MASKED_S; }
        else { sa[r] = 0.f; sb[r] = 0.f; }
    }
    const int krow = keyperm(n);
#pragma unroll
    for (int s = 0; s < NKS; ++s) {
        const bf16x8 ka = *(const LAS bf16x8*)(kl + k_lds_off<NKS>(krow, 2 * s + hi)), kb = *(const LAS bf16x8*)(kl + k_lds_off<NKS>(32 + krow, 2 * s + hi));
        sa = MFMA32(ka, qf[s], sa); sb = MFMA32(kb, qf[s], sb);
    }
}
DI void smpv64(AttnState& st, f32x16& sa, f32x16& sb, const LAS char* vl, int lane) {
    float tmax;
    asm volatile("s_nop 7\n\ts_nop 7\n\ts_nop 1\n\tv_max3_f32 %0, %1, %2, %3" : "=v"(tmax) : "v"(sa[0]), "v"(sb[0]), "v"(M_FLOOR));
#pragma unroll
    for (int r = 1; r < 16; ++r) tmax = max3f(tmax, sa[r], sb[r]);
    tmax = fmaxf(tmax, shfl_xor_l(tmax, 32, lane));
    float mn = st.m;
    if (__builtin_amdgcn_ballot_w64(tmax > st.m + RESC_THR) != 0ull) {
        mn = fmaxf(st.m, tmax);
        const float alpha = __builtin_amdgcn_exp2f(st.m - mn);
        st.l *= alpha; st.m = mn;
#pragma unroll
        for (int r = 0; r < 16; ++r) { st.o0[r] *= alpha; st.o1[r] *= alpha; }
    }
    float rsum = 0.f;
#pragma unroll
    for (int r = 0; r < 16; r += 2) {
        const f32x2 mm = {mn, mn}; const f32x2 ta = (f32x2){sa[r], sa[r + 1]} - mm, tb = (f32x2){sb[r], sb[r + 1]} - mm;
        const float pa0 = __builtin_amdgcn_exp2f(ta[0]), pa1 = __builtin_amdgcn_exp2f(ta[1]), pb0 = __builtin_amdgcn_exp2f(tb[0]), pb1 = __builtin_amdgcn_exp2f(tb[1]);
        sa[r] = pa0; sa[r + 1] = pa1; sb[r] = pb0; sb[r + 1] = pb1; rsum += (pa0 + pa1) + (pb0 + pb1); }
    st.l += rsum;
    bf16x8 pfa[2], pfb[2];
#pragma unroll
    for (int s = 0; s < 2; ++s) {
        u32x4 w; w.x = pk2(sa[8 * s], sa[8 * s + 1]); w.y = pk2(sa[8 * s + 2], sa[8 * s + 3]); w.z = pk2(sa[8 * s + 4], sa[8 * s + 5]); w.w = pk2(sa[8 * s + 6], sa[8 * s + 7]); pfa[s] = __builtin_bit_cast(bf16x8, w);
        u32x4 v; v.x = pk2(sb[8 * s], sb[8 * s + 1]); v.y = pk2(sb[8 * s + 2], sb[8 * s + 3]); v.z = pk2(sb[8 * s + 4], sb[8 * s + 5]); v.w = pk2(sb[8 * s + 6], sb[8 * s + 7]); pfb[s] = __builtin_bit_cast(bf16x8, v);
    }
    const int g = lane >> 4, i16 = lane & 15, q = i16 >> 2, p = i16 & 3;
    const LAS char* vr = vl + (8 * (g >> 1) + q) * VT_STRIDE + (16 * (g & 1) + 4 * p) * 2;
#pragma unroll
    for (int sub = 0; sub < 2; ++sub)
#pragma unroll
        for (int db = 0; db < 2; ++db)
#pragma unroll
            for (int s = 0; s < 2; ++s) {
                const s16x4 lo = vtr(vr + (32 * sub + 16 * s) * VT_STRIDE + 64 * db), hi4 = vtr(vr + (32 * sub + 16 * s + 4) * VT_STRIDE + 64 * db);
                const bf16x8 vf = __builtin_shufflevector(lo, hi4, 0, 1, 2, 3, 4, 5, 6, 7);
                const bf16x8 pf = sub == 0 ? pfa[s] : pfb[s];
                if (db == 0) st.o0 = MFMA32(vf, pf, st.o0); else st.o1 = MFMA32(vf, pf, st.o1);
            }
}
template <int NKS, bool ANYMASK, class MaskF>
DI void attn_core64(AttnState& st, const bf16x8 (&qf)[NKS], const LAS char* kl, const LAS char* vl, int lane, const MaskF& mask) {
    f32x16 sa, sb; qk64<NKS, ANYMASK>(sa, sb, qf, kl, lane, mask); smpv64(st, sa, sb, vl, lane);
}
struct Mask64None { DI bool operator()(int, int, int, int) const { return true; } };
struct Mask64Causal { int ta, tb, tw; DI bool operator()(int sub, int n, int kk, int) const { const int t = sub == 0 ? ta : tb; return t < tw || (t == tw && kk <= n); } };
struct Mask64Bits { unsigned ba, bb; DI bool operator()(int sub, int, int, int r) const { return ((sub == 0 ? ba : bb) >> r) & 1u; } };
template <int NKS, class MaskF>
DI void attn_tile(AttnState& st, const bf16x8 (&qf)[NKS], const KVTile<NKS>& T, LAS char* kl, LAS char* vl, int lane, const MaskF& mask) {
#pragma unroll
    for (int j = 0; j < NKS; ++j) { const int cid = lane + 64 * j; *(LAS u32x4*)(kl + k_lds_off<NKS>(cid / (2 * NKS), cid % (2 * NKS))) = T.kc[j]; }
#pragma unroll
    for (int j = 0; j < 4; ++j) { const int cid = lane + 64 * j; *(LAS u32x4*)(vl + (cid >> 3) * VT_STRIDE + (cid & 7) * 16) = T.vc[j]; }
    attn_core<NKS>(st, qf, kl, vl, 0, lane, mask);
}
DI void attn_store(const AttnState& st, bf16_t* orow  , int lane) {
    const int hi = lane >> 5;
    const float lt = st.l + shfl_xor_l(st.l, 32, lane); const float inv = 1.f / lt;
#pragma unroll
    for (int rg = 0; rg < 4; ++rg) {
        f32x4 a = {st.o0[4 * rg] * inv, st.o0[4 * rg + 1] * inv, st.o0[4 * rg + 2] * inv, st.o0[4 * rg + 3] * inv};
        f32x4 b = {st.o1[4 * rg] * inv, st.o1[4 * rg + 1] * inv, st.o1[4 * rg + 2] * inv, st.o1[4 * rg + 3] * inv};
        *(u32x2*)(orow + 8 * rg + 4 * hi) = pk4(a); *(u32x2*)(orow + 32 + 8 * rg + 4 * hi) = pk4(b);
    }
}

struct MaskBits { unsigned bits; DI bool operator()(int, int, int r) const { return (bits >> r) & 1u; } };
struct MaskNone { DI bool operator()(int, int, int) const { return true; } };
struct MaskCausal { DI bool operator()(int n, int kk, int) const { return kk <= n; } };
struct MaskWin { int d0, stride; unsigned lim; DI bool operator()(int, int, int r) const { return (unsigned)(d0 - stride * (16 * (r >> 3) + (r & 7))) <= lim; } };

#ifndef ATT_VARIANT
#define ATT_VARIANT 0
#endif
template <int NKS>
DI void attn_probe_core(AttnState& st, const bf16x8 (&qf)[NKS], const LAS char* kl, int lane, int variant) {
    if (variant < 2) return;
    const int hi = lane >> 5, n = lane & 31;
    f32x16 sa, sb;
#pragma unroll
    for (int r = 0; r < 16; ++r) { sa[r] = 0.f; sb[r] = 0.f; }
    const int krow = keyperm(n);
    bf16x8 ka[NKS], kb[NKS];
#pragma unroll
    for (int s = 0; s < NKS; ++s) { ka[s] = *(const LAS bf16x8*)(kl + k_lds_off<NKS>(krow, 2 * s + hi)); kb[s] = *(const LAS bf16x8*)(kl + k_lds_off<NKS>(32 + krow, 2 * s + hi)); }
    __builtin_amdgcn_sched_barrier(0);
#pragma unroll
    for (int s = 0; s < NKS; ++s) { sa = MFMA32(ka[s], qf[s], sa); sb = MFMA32(kb[s], qf[s], sb); }
    if (variant == 2) {
#pragma unroll
        for (int r = 0; r < 16; ++r) st.o0[r] += sa[r] + sb[r];
        return;
    }
    float tmax = NEG_BIG;
#pragma unroll
    for (int r = 0; r < 16; ++r) tmax = fmaxf(tmax, fmaxf(sa[r], sb[r]));
    tmax = fmaxf(tmax, shfl_xor_l(tmax, 32, lane));
    const float mn = fmaxf(st.m, tmax);
    if (__builtin_amdgcn_ballot_w64(mn > st.m) != 0ull) { const float alpha = __builtin_amdgcn_exp2f(st.m - mn); st.l *= alpha; st.m = mn;
#pragma unroll
        for (int r = 0; r < 16; ++r) { st.o0[r] *= alpha; st.o1[r] *= alpha; } }
    float rsum = 0.f; unsigned acc = 0u;
#pragma unroll
    for (int r = 0; r < 16; ++r) { const float pa = __builtin_amdgcn_exp2f(sa[r] - mn), pb = __builtin_amdgcn_exp2f(sb[r] - mn); rsum += pa + pb; acc ^= pk2(pa, pb); }
    st.l += rsum; st.o1[0] += __uint_as_float(acc & 0x3fffffffu);
}
constexpr size_t OFF_MASKG = (OFF_Z + ZEND + 255) & ~(size_t)255;
static_assert(OFF_MASKG + (size_t)NB * 32896 * 128 <= 512 * MiB, "mask words fit the workspace");
DI size_t maskg_word(int b, int qb, int tile) { return ((size_t)b * 32896 + (size_t)(qb * (qb + 1) / 2 + tile)) * 32; }
template <int NKS> constexpr int stage_bytes() { return (NKS == 4 ? 64 * 128 : 64 * 208) + 64 * VT_STRIDE; }
#define VMWAIT(n) asm volatile("s_waitcnt vmcnt(" #n ")" ::: "memory")
template <int NKS, bool MASKED, bool PIPE>
DI void attn_shared_unit(LAS unsigned char* lds, const bf16_t* qrowp  , const char* kg  , int krb,
                         const char* vg, int vrb, const unsigned* maskq  , bf16_t* orow, int Q, int wave, int lane, int variant) {
    constexpr int KIMG = NKS == 4 ? 64 * 128 : 64 * 208, STAGE = stage_bytes<NKS>();
    constexpr int NPK = KIMG / 1024, NPV = 64 * VT_STRIDE / 1024, NP = NPK + NPV, NPW = (NP + 7) / 8;
    constexpr int MSK_OFF = 4 * STAGE;
    const int hi = lane >> 5, n = lane & 31;
    bf16x8 qf[NKS];
#pragma unroll
    for (int s = 0; s < NKS; ++s) qf[s] = *(const bf16x8*)(qrowp + 16 * s + 8 * hi);
    AttnState st; attn_init(st);
    unsigned goff[NPW]; int loff[NPW]; bool isv[NPW];
#pragma unroll
    for (int k = 0; k < NPW; ++k) {
        int pc = wave + 8 * k; if (pc >= NP) pc -= NP;
        if (pc < NPK) { isv[k] = false; loff[k] = pc * 1024;
            if (NKS == 4) { const int row = 8 * pc + (lane >> 3), ch = (lane & 7) ^ ((lane >> 3) & 7); goff[k] = (unsigned)(row * krb + ch * 16); }
            else { const int sidx = 64 * pc + lane, row = sidx / 13, c = sidx % 13; goff[k] = (unsigned)(row * krb + (c < 12 ? c : 0) * 16); } }
        else { const int pv = pc - NPK; isv[k] = true; loff[k] = KIMG + pv * 1024; const int sidx = 64 * pv + lane, row = sidx / 12, c = sidx % 12; goff[k] = (unsigned)(row * vrb + (c < 8 ? c : 0) * 16); }
    }
    const int tw = 8 * Q + wave, nst = 4 * Q + 4;
    const unsigned* mq = maskq + n;
#define GLDS16(gp, ldsaddr) do { unsigned keep_; asm volatile("s_mov_b32 %0, m0\n\ts_mov_b32 m0, %2\n\ts_nop 0\n\tglobal_load_lds_dwordx4 %1, off\n\ts_mov_b32 m0, %0" : "=&s"(keep_) : "v"(gp), "s"(ldsaddr) : "memory"); } while (0)
#define GLDS4(gp, ldsaddr) do { unsigned keep_; asm volatile("s_mov_b32 %0, m0\n\ts_mov_b32 m0, %2\n\ts_nop 0\n\tglobal_load_lds_dword %1, off\n\ts_mov_b32 m0, %0" : "=&s"(keep_) : "v"(gp), "s"(ldsaddr) : "memory"); } while (0)
    const unsigned lds0 = (unsigned)(size_t)lds;
#define STG_DMA(jj) do { const int j_ = (jj); const unsigned sb_ = lds0 + (unsigned)((j_ & 3) * STAGE); \
        _Pragma("unroll") for (int k = 0; k < NPW; ++k) { const char* gp_ = (isv[k] ? vg + (size_t)j_ * 64 * vrb : kg + (size_t)j_ * 64 * krb) + goff[k]; \
            const unsigned la_ = (unsigned)__builtin_amdgcn_readfirstlane((int)(sb_ + (unsigned)loff[k])); GLDS16(gp_, la_); } \
        if (MASKED) { int t_ = 2 * j_ + hi; t_ = t_ <= tw ? t_ : tw; const unsigned* mp_ = mq + (size_t)t_ * 32; \
            const unsigned la_ = (unsigned)__builtin_amdgcn_readfirstlane((int)(lds0 + (unsigned)(MSK_OFF + wave * 1024 + (j_ & 3) * 256))); GLDS4(mp_, la_); } } while (0)
    constexpr int NL = NPW + (MASKED ? 1 : 0);
#define VMWAIT_NL(mult) do { if (NL * (mult) == 3) VMWAIT(3); else if (NL * (mult) == 4) VMWAIT(4); else if (NL * (mult) == 5) VMWAIT(5); else if (NL * (mult) == 6) VMWAIT(6); else if (NL * (mult) == 8) VMWAIT(8); else VMWAIT(10); } while (0)
#define STG_MASK(jj, ba, bb) unsigned ba = 0u, bb = 0u; if (MASKED) { const LAS unsigned* mw_ = (const LAS unsigned*)(lds + MSK_OFF + wave * 1024 + ((jj) & 3) * 256); \
        const unsigned m0_ = mw_[n], m1_ = mw_[32 + n]; ba = ((m0_ >> (8 * hi)) & 0xffu) | (((m0_ >> (16 + 8 * hi)) & 0xffu) << 8); \
        bb = 2 * (jj) + 1 <= tw ? ((m1_ >> (8 * hi)) & 0xffu) | (((m1_ >> (16 + 8 * hi)) & 0xffu) << 8) : 0u; }
    __builtin_amdgcn_s_waitcnt(0x0F70);
    asm volatile("s_barrier" ::: "memory");
    STG_DMA(0); STG_DMA(1); STG_DMA(2);
    VMWAIT_NL(2);
    asm volatile("s_barrier" ::: "memory");
    st.m = M_FLOOR;
    f32x16 sa, sb;
#define STG_QK(SA_, SB_, jj) do { const int j_ = (jj); const LAS char* kb_ = (const LAS char*)lds + (j_ & 3) * STAGE; \
        if (MASKED) { STG_MASK(j_, ba_, bb_); qk64<NKS, true>(SA_, SB_, qf, kb_, lane, Mask64Bits{ba_, bb_}); } \
        else if (2 * j_ + 1 < tw) qk64<NKS, false>(SA_, SB_, qf, kb_, lane, Mask64None{}); \
        else qk64<NKS, true>(SA_, SB_, qf, kb_, lane, Mask64Causal{2 * j_, 2 * j_ + 1, tw}); } while (0)
    if (PIPE) STG_QK(sa, sb, 0);
    for (int j = 0; j < nst; ++j) {
        if (j + 1 < nst) { if (j + 2 < nst) VMWAIT_NL(1); else VMWAIT(0); }
        asm volatile("s_barrier" ::: "memory");
        if (j + 3 < nst) STG_DMA(j + 3);
        const LAS char* cur = (const LAS char*)lds + (j & 3) * STAGE;
        const bool an = j + 1 < nst && 2 * (j + 1) <= tw, ac = 2 * j <= tw;
        if (!PIPE) { if (ac) { STG_QK(sa, sb, j); smpv64(st, sa, sb, cur + KIMG, lane); } }
        else {
        f32x16 sa2, sb2;
        if (an && ac && (MASKED || 2 * (j + 1) + 1 < tw)) {
            if (MASKED) { STG_MASK(j + 1, ba_, bb_); qk64<NKS, true>(sa2, sb2, qf, (const LAS char*)lds + ((j + 1) & 3) * STAGE, lane, Mask64Bits{ba_, bb_}); }
            else qk64<NKS, false>(sa2, sb2, qf, (const LAS char*)lds + ((j + 1) & 3) * STAGE, lane, Mask64None{});
            smpv64(st, sa, sb, cur + KIMG, lane);
        } else {
            if (an) STG_QK(sa2, sb2, j + 1);
            if (ac) smpv64(st, sa, sb, cur + KIMG, lane);
        }
        if (an) { sa = sa2; sb = sb2; }
        }
    }
#undef STG_QK
#undef VMWAIT_NL
#undef STG_MASK
#undef STG_DMA
#undef GLDS16
#undef GLDS4
    attn_store(st, orow, lane);
}
DI void phase_attn_shared(const Bufs& B, LAS unsigned char* lds, int G, int wave, int lane_in, int variant) {
    const int vcu = (G % 8 == 0) ? ((int)blockIdx.x & 7) * (G / 8) + ((int)blockIdx.x >> 3) : (int)blockIdx.x;
    for (int pc = vcu; pc < 256; pc += G) {
        const int xg = pc >> 5, qi_ = pc & 31;
#pragma unroll 1
        for (int k = 0; k < 4; ++k) {
            int lane = lane_in; asm volatile("" : "+v"(lane));
            const int bh = 2 * xg + (k & 1), b = bh >> 2, h = bh & 3;
            const int Q = (k & 1) ? 31 - qi_ : qi_; const int n = lane & 31;
            const size_t qrow = (size_t)b * S + 256 * Q + 32 * wave + n;
            if (k < 2) attn_shared_unit<6, false, false>(lds, B.QM() + (qrow * 4 + h) * 96, (const char*)(B.KM() + ((size_t)b * S * 4 + h) * 96), 768, (const char*)(B.VM() + ((size_t)b * S * 4 + h) * 64), 512,
                                                  nullptr, variant ? (bf16_t*)(B.ws + OFF_DUMP) + lane * 64 : B.MIX() + qrow * D + h * 64, Q, wave, lane, variant);
            else attn_shared_unit<4, true, true>(lds, B.SQ() + (qrow * 4 + h) * 64, (const char*)(B.SK() + ((size_t)b * S * 4 + h) * 64), 512, (const char*)(B.SV() + ((size_t)b * S * 4 + h) * 64), 512,
                                           (const unsigned*)(B.ws + OFF_MASKG) + maskg_word(b, 8 * Q + wave, 0), variant ? (bf16_t*)(B.ws + OFF_DUMP) + lane * 64 : B.MIX() + qrow * D + 768 + h * 64, Q, wave, lane, variant);
        }
    }
    __syncthreads();
}

DI void phase_dil(const Bufs& B, LAS unsigned char* lds, int gw, int NGW, int wave, int lane) {
    LAS char* kl = (LAS char*)lds + wave * (4096 + VT_BYTES); LAS char* vl = kl + 4096;
    const int hi = lane >> 5, n = lane & 31;
    for (int task = gw; task < NB * 8 * 16 * 16; task += NGW) {
        const int ib = task & 15, r16 = (task >> 4) & 15, hd = (task >> 8) & 7, b = task >> 11;
        const int tq = r16 + 16 * (32 * ib + n);
        const size_t qrow = (size_t)b * S + tq;
        bf16x8 qf[4];
#pragma unroll
        for (int s = 0; s < 4; ++s) qf[s] = *(const bf16x8*)(B.DQ() + (qrow * 8 + hd) * 64 + 16 * s + 8 * hi);
        AttnState st; attn_init(st);
        const rsrc_t kr = make_rsrc(B.DK() + ((size_t)b * S * 8 + hd) * 64), vr = make_rsrc(B.DV() + ((size_t)b * S * 8 + hd) * 64);
#pragma unroll 1
        for (int pr = 0; pr < 3; ++pr) {
            const int stride = pr == 0 ? 16 : (pr == 1 ? 4 : 1), ntile = pr == 0 ? 5 : (pr == 1 ? 8 : 20);
            const int base0 = pr == 0 ? r16 + 16 * (32 * ib - 128) : (pr == 1 ? (r16 & 3) + 4 * ((r16 >> 2) + 128 * ib - 128) : r16 + 512 * ib - 128);
            KVTile<4> T;
            { unsigned ko[4];
#pragma unroll
              for (int j = 0; j < 4; ++j) { int tk = base0 + stride * ((lane >> 3) + 8 * j); tk = tk < 0 ? 0 : (tk > S - 1 ? S - 1 : tk); ko[j] = (unsigned)(tk * 1024 + (lane & 7) * 16); }
              kv_load<4>(T, kr, ko, 0, vr, ko, 0); }
            for (int u = 0; u < ntile; ++u) {
                const int base = base0 + stride * 32 * u;
                KVTile<4> Tn;
                if (u + 1 < ntile) { unsigned ko[4];
#pragma unroll
                    for (int j = 0; j < 4; ++j) { int tk = base + stride * 32 + stride * ((lane >> 3) + 8 * j); tk = tk < 0 ? 0 : (tk > S - 1 ? S - 1 : tk); ko[j] = (unsigned)(tk * 1024 + (lane & 7) * 16); }
                    kv_load<4>(Tn, kr, ko, 0, vr, ko, 0); }
                attn_tile<4>(st, qf, T, kl, vl, lane, MaskWin{tq - base - 8 * hi * stride, stride, (unsigned)min(128 * stride, tq)});
                T = Tn;
            }
        }
        attn_store(st, B.MIX() + qrow * D + 256 + hd * 64, lane);
    }
}

constexpr int D2_KV = 4096 + VT_BYTES, D2_OBUF = 8 * D2_KV, D2_OSTR = 136, D2_ML = D2_OBUF + 512 * D2_OSTR;
static_assert(D2_ML + 512 * 8 <= LDS_MISC, "dilated LDS map");
DI void phase_dil2(const Bufs& B, LAS unsigned char* lds, int G, int wave, int lane_in) {
    const int vcu = (G % 8 == 0) ? ((int)blockIdx.x & 7) * (G / 8) + ((int)blockIdx.x >> 3) : (int)blockIdx.x;
    LAS char* kl = (LAS char*)lds + wave * D2_KV; LAS char* vl = kl + 4096;
    for (int unit = vcu; unit < NB * 8 * 16; unit += G) {
        const int sp = unit & 15, hd = (unit >> 4) & 7, b = unit >> 7, T0 = 512 * sp;
        const rsrc_t kr = make_rsrc(B.DK() + ((size_t)b * S * 8 + hd) * 64), vr = make_rsrc(B.DV() + ((size_t)b * S * 8 + hd) * 64);
        __syncthreads();
#pragma unroll 1
        for (int pr = 0; pr < 3; ++pr) {
            const int stride = pr == 0 ? 16 : (pr == 1 ? 4 : 1);
#pragma unroll 1
            for (int tk = wave; tk < 16; tk += 8) {
                int lane = lane_in; asm volatile("" : "+v"(lane));
                const int hi = lane >> 5, n = lane & 31;
                const int tf = pr == 0 ? T0 + tk : (pr == 1 ? T0 + (tk & 3) + 128 * (tk >> 2) : T0 + 32 * tk);
                const int tq = tf + stride * n; const size_t qrow = (size_t)b * S + tq;
                bf16x8 qf[4];
#pragma unroll
                for (int s4 = 0; s4 < 4; ++s4) qf[s4] = *(const bf16x8*)(B.DQ() + (qrow * 8 + hd) * 64 + 16 * s4 + 8 * hi);
                AttnState st; attn_init(st); st.m = -1e20f;
                const int base0 = tf - 128 * stride;
                KVTile<4> T;
                { unsigned ko[4];
#pragma unroll
                  for (int j = 0; j < 4; ++j) { int t2 = base0 + stride * ((lane >> 3) + 8 * j); t2 = t2 < 0 ? 0 : t2; ko[j] = (unsigned)(t2 * 1024 + (lane & 7) * 16); }
                  kv_load<4>(T, kr, ko, 0, vr, ko, 0); }
#pragma unroll 1
                for (int u = 0; u < 5; ++u) {
                    const int base = base0 + stride * 32 * u;
                    KVTile<4> Tn;
                    if (u < 4) { unsigned ko[4];
#pragma unroll
                        for (int j = 0; j < 4; ++j) { int t2 = base + stride * 32 + stride * ((lane >> 3) + 8 * j); t2 = t2 < 0 ? 0 : (t2 > S - 1 ? S - 1 : t2); ko[j] = (unsigned)(t2 * 1024 + (lane & 7) * 16); }
                        kv_load<4>(Tn, kr, ko, 0, vr, ko, 0); }
                    attn_tile<4>(st, qf, T, kl, vl, lane, MaskWin{tq - base - 8 * hi * stride, stride, (unsigned)min(128 * stride, tq)});
                    T = Tn;
                }
                LAS char* orow = (LAS char*)lds + D2_OBUF + (tq - T0) * D2_OSTR + 8 * hi;
                LAS f32x2* mlp = (LAS f32x2*)(lds + D2_ML) + (tq - T0);
                float lt = st.l + shfl_xor_l(st.l, 32, lane);
                if (pr > 0) {
                    const f32x2 ml = *mlp; const float mn = fmaxf(st.m, ml[0]);
                    const float a1 = __builtin_amdgcn_exp2f(st.m - mn), a2 = __builtin_amdgcn_exp2f(ml[0] - mn);
                    lt = lt * a1 + ml[1] * a2; st.m = mn;
#pragma unroll
                    for (int rg = 0; rg < 4; ++rg) {
                        const u32x2 p0 = *(const LAS u32x2*)(orow + 16 * rg), p1 = *(const LAS u32x2*)(orow + 64 + 16 * rg);
#pragma unroll
                        for (int e = 0; e < 4; ++e) {
                            const float f0 = __uint_as_float(((e & 1) ? (e < 2 ? p0.x : p0.y) & 0xffff0000u : (e < 2 ? p0.x : p0.y) << 16));
                            const float f1 = __uint_as_float(((e & 1) ? (e < 2 ? p1.x : p1.y) & 0xffff0000u : (e < 2 ? p1.x : p1.y) << 16));
                            st.o0[4 * rg + e] = st.o0[4 * rg + e] * a1 + f0 * a2; st.o1[4 * rg + e] = st.o1[4 * rg + e] * a1 + f1 * a2;
                        }
                    }
                }
                if (pr < 2) {
#pragma unroll
                    for (int rg = 0; rg < 4; ++rg) {
                        *(LAS u32x2*)(orow + 16 * rg) = pk4((f32x4){st.o0[4 * rg], st.o0[4 * rg + 1], st.o0[4 * rg + 2], st.o0[4 * rg + 3]});
                        *(LAS u32x2*)(orow + 64 + 16 * rg) = pk4((f32x4){st.o1[4 * rg], st.o1[4 * rg + 1], st.o1[4 * rg + 2], st.o1[4 * rg + 3]});
                    }
                    if (hi == 0) *mlp = (f32x2){st.m, lt};
                } else {
                    const float inv = 1.f / lt; bf16_t* og = B.MIX() + qrow * D + 256 + hd * 64;
#pragma unroll
                    for (int rg = 0; rg < 4; ++rg) {
                        *(u32x2*)(og + 8 * rg + 4 * hi) = pk4((f32x4){st.o0[4 * rg] * inv, st.o0[4 * rg + 1] * inv, st.o0[4 * rg + 2] * inv, st.o0[4 * rg + 3] * inv});
                        *(u32x2*)(og + 32 + 8 * rg + 4 * hi) = pk4((f32x4){st.o1[4 * rg] * inv, st.o1[4 * rg + 1] * inv, st.o1[4 * rg + 2] * inv, st.o1[4 * rg + 3] * inv});
                    }
                }
            }
            __syncthreads();
        }
    }
    __syncthreads();
}

constexpr int DSA_CAP = 576;
constexpr int DL_HIST = 0;
constexpr int DL_CAND = 0, DL_WHIST = 32 * DSA_CAP * 8;
constexpr int DL_MISC = DL_WHIST + 16 * 512;
static_assert(DL_MISC + 2048 <= LDS_MISC, "DSA LDS map");
DI unsigned sortable_u(float f) { const unsigned u = __float_as_uint(f); return u ^ ((unsigned)((int)u >> 31) | 0x80000000u); }
DI void idx_scores(f32x16& sc, const bf16x8 (&kif)[2], const bf16x8 (&q)[8][2], const bf16x8 (&qt)[2], const float* whp  ) {
    const f32x4 wa = *(const f32x4*)whp, wb = *(const f32x4*)(whp + 4); const float wh[8] = {wa[0], wa[1], wa[2], wa[3], wb[0], wb[1], wb[2], wb[3]};
#pragma unroll
    for (int r = 0; r < 16; ++r) sc[r] = 0.f;
    sc = MFMA32(kif[0], qt[0], sc); sc = MFMA32(kif[1], qt[1], sc);
    f32x16 d[8];
#pragma unroll
    for (int hh = 0; hh < 8; ++hh) {
#pragma unroll
        for (int r = 0; r < 16; ++r) d[hh][r] = 0.f;
        d[hh] = MFMA32(kif[0], q[hh][0], d[hh]); d[hh] = MFMA32(kif[1], q[hh][1], d[hh]);
    }
    asm volatile("s_nop 7\n\ts_nop 3\n\tv_fma_f32 %0, |%1|, %2, %0" : "+v"(sc[0]) : "v"(d[0][0]), "v"(wh[0]), "v"(d[1][15]), "v"(d[2][15]), "v"(d[3][15]), "v"(d[4][15]), "v"(d[5][15]), "v"(d[6][15]), "v"(d[7][15]));
#pragma unroll
    for (int hh = 0; hh < 8; ++hh)
#pragma unroll
        for (int r = (hh == 0 ? 1 : 0); r < 16; ++r) asm volatile("v_fma_f32 %0, |%1|, %2, %0" : "+v"(sc[r]) : "v"(d[hh][r]), "v"(wh[hh]));
}
DI int wave_excl_scan(int x, int lane) {
    int v = x;
#pragma unroll
    for (int d = 1; d < 64; d <<= 1) { const int o = __builtin_amdgcn_ds_bpermute((lane - d) << 2, v); if (lane >= d) v += o; }
    return v - x;
}

DI void phase_dsa(const Bufs& B, LAS unsigned char* lds, int G, int wave, int lane_in) {
    LAS int* thrbin = (LAS int*)(lds + DL_MISC); LAS int* need = thrbin + 32; LAS unsigned* cnt = (LAS unsigned*)(need + 32); LAS u64* thr = (LAS u64*)(lds + DL_MISC + 512);
    for (int pi = blockIdx.x; pi < 512; pi += G) {
#pragma unroll 1
        for (int half = 0; half < 2; ++half) {
            int lane = lane_in; asm volatile("" : "+v"(lane));
            const int hi = lane >> 5, n = lane & 31, tid = wave * 64 + lane;
            const int b = pi >> 7, i = pi & 127, qb = half == 0 ? i : 255 - i;
            const int tq = 32 * qb + n; const size_t qrow = (size_t)b * S + tq;
            unsigned* maskw = (unsigned*)(B.ws + OFF_MASKG) + maskg_word(b, qb, 0);
            __syncthreads();
            {
            float w[8];
            { const f32x4 w0 = *(const f32x4*)(B.WI() + qrow * 8), w1 = *(const f32x4*)(B.WI() + qrow * 8 + 4);
              w[0] = w0[0]; w[1] = w0[1]; w[2] = w0[2]; w[3] = w0[3]; w[4] = w1[0]; w[5] = w1[1]; w[6] = w1[2]; w[7] = w1[3]; }
            bf16x8 qi[8][2];
#pragma unroll
            for (int hh = 0; hh < 8; ++hh)
#pragma unroll
                for (int s = 0; s < 2; ++s) qi[hh][s] = *(const bf16x8*)(B.QI() + (qrow * 8 + hh) * 32 + 16 * s + 8 * hi);
            bf16x8 qt[2];
#pragma unroll
            for (int s2 = 0; s2 < 2; ++s2) { float a8[8];
#pragma unroll
                for (int j = 0; j < 8; ++j) a8[j] = 0.f;
#pragma unroll
                for (int hh = 0; hh < 8; ++hh)
#pragma unroll
                    for (int j = 0; j < 8; ++j) a8[j] += w[hh] * bf2f((bf16_t)qi[hh][s2][j]);
                u32x4 pw; pw.x = pk2(a8[0], a8[1]); pw.y = pk2(a8[2], a8[3]); pw.z = pk2(a8[4], a8[5]); pw.w = pk2(a8[6], a8[7]); qt[s2] = __builtin_bit_cast(bf16x8, pw); }
            const float* whp = B.WI() + qrow * 8;
#define DSA_KIB() const bf16_t* kib; { int l2_ = lane_in; asm volatile("" : "+v"(l2_)); kib = B.KI() + ((size_t)b * S + keyperm(l2_ & 31)) * 32 + 8 * (l2_ >> 5); }
#ifndef DSA_REP_A
#define DSA_REP_A 1
#endif
#ifndef DSA_REP_B
#define DSA_REP_B 1
#endif
#ifndef DSA_REP_C
#define DSA_REP_C 1
#endif
            for (int repa_ = 0; repa_ < DSA_REP_A; ++repa_) {
            __syncthreads();
            { LAS u32x4* h4 = (LAS u32x4*)(lds + DL_HIST); unsigned zz = 0u; asm volatile("" : "+v"(zz)); const u32x4 z = {zz, zz, zz, zz};
#pragma unroll
              for (int k = 0; k < 16; ++k) h4[tid + 512 * k] = z; }
            __syncthreads();
            DSA_KIB()
            for (int kt0 = wave; kt0 <= qb; kt0 += 8) {
              bf16x8 kb4[1][2];
#pragma unroll
              for (int i4 = 0; i4 < 1; ++i4) { const int ktc = min(kt0 + 8 * i4, qb); kb4[i4][0] = *(const bf16x8*)(kib + (size_t)ktc * 32 * 32); kb4[i4][1] = *(const bf16x8*)(kib + (size_t)ktc * 32 * 32 + 16); }
#pragma unroll
              for (int i4 = 0; i4 < 1; ++i4) { const int kt = kt0 + 8 * i4; if (kt > qb) break;
                bf16x8 kif[2]; kif[0] = kb4[i4][0]; kif[1] = kb4[i4][1];
                int wo_ = 0; asm volatile("" : "+v"(wo_)); f32x16 sc; idx_scores(sc, kif, qi, qt, whp + wo_);
                int lq_ = lane_in; asm volatile("" : "+v"(lq_));
                const int lim = 32 * qb + (lq_ & 31) - 32 * kt - 8 * (lq_ >> 5);
#pragma unroll
                for (int r = 0; r < 16; ++r) { const unsigned bin = sortable_u(sc[r]) >> 21;
                    atomicAdd((unsigned*)(lds + DL_HIST + 4 * (n * 1024 + (bin >> 1))), 1u << (16 * (bin & 1))); }
                if (kt == qb) {
#pragma unroll
                    for (int r = 0; r < 16; ++r) { const unsigned bin = sortable_u(sc[r]) >> 21;
                        if (16 * (r >> 3) + (r & 7) > lim) atomicAdd((unsigned*)(lds + DL_HIST + 4 * (n * 1024 + (bin >> 1))), 0u - (1u << (16 * (bin & 1)))); } }
              }
            }
            }
            __syncthreads();
#pragma unroll 1
            for (int rp = 0; rp < 2; ++rp) {
                int ln = lane_in; asm volatile("" : "+v"(ln));
                const int row0 = wave * 4 + 2 * rp;
                const int wbase = 1023 - 16 * ln - 15;
                unsigned wds[2][16]; int cs[2];
#pragma unroll
                for (int q = 0; q < 2; ++q) { const LAS unsigned* hw = (const LAS unsigned*)(lds + DL_HIST) + (row0 + q) * 1024 + wbase;
#pragma unroll
                    for (int k = 0; k < 4; ++k) { const u32x4 v = *(const LAS u32x4*)(hw + 4 * k); wds[q][4 * k] = v.x; wds[q][4 * k + 1] = v.y; wds[q][4 * k + 2] = v.z; wds[q][4 * k + 3] = v.w; } }
#pragma unroll
                for (int q = 0; q < 2; ++q) { int c = 0;
#pragma unroll
                    for (int k = 0; k < 16; ++k) c += (int)(wds[q][k] & 0xffffu) + (int)(wds[q][k] >> 16);
                    cs[q] = c; }
                int v0 = cs[0], v1 = cs[1];
#pragma unroll
                for (int d = 1; d < 64; d <<= 1) { const int o0 = __builtin_amdgcn_ds_bpermute((ln - d) << 2, v0), o1 = __builtin_amdgcn_ds_bpermute((ln - d) << 2, v1); if (ln >= d) { v0 += o0; v1 += o1; } }
                const int pres[2] = {v0 - cs[0], v1 - cs[1]};
#pragma unroll
                for (int q = 0; q < 2; ++q) { const int row = row0 + q; const int total = 32 * qb + row + 1; int pre = pres[q];
                    if (total <= 256) { if (ln == 0) { thrbin[row] = -1; need[row] = 0; } }
                    else if (pre < 256 && pre + cs[q] >= 256) {
                        int tb = 0, nd = 1; bool found = false;
#pragma unroll
                        for (int k = 15; k >= 0; --k) {
                            const int bh = (int)(wds[q][k] >> 16), bl = (int)(wds[q][k] & 0xffffu); const int binh = 2 * (wbase + k) + 1;
                            if (!found) { if (pre + bh >= 256) { tb = binh; nd = 256 - pre; found = true; } else pre += bh; }
                            if (!found) { if (pre + bl >= 256) { tb = binh - 1; nd = 256 - pre; found = true; } else pre += bl; }
                        }
                        thrbin[row] = tb; need[row] = nd;
                    } }
            }
            for (int repb_ = 0; repb_ < DSA_REP_B; ++repb_) {
            __syncthreads();
            if (tid < 32) cnt[tid] = 0u;
            __syncthreads();
            { const int tb = thrbin[n]; DSA_KIB()
              for (int kt0 = wave; kt0 <= qb; kt0 += 8) {
               bf16x8 kb4[1][2];
#pragma unroll
               for (int i4 = 0; i4 < 1; ++i4) { const int ktc = min(kt0 + 8 * i4, qb); kb4[i4][0] = *(const bf16x8*)(kib + (size_t)ktc * 32 * 32); kb4[i4][1] = *(const bf16x8*)(kib + (size_t)ktc * 32 * 32 + 16); }
#pragma unroll
               for (int i4 = 0; i4 < 1; ++i4) { const int kt = kt0 + 8 * i4; if (kt > qb) break;
                bf16x8 kif[2]; kif[0] = kb4[i4][0]; kif[1] = kb4[i4][1];
                int wo_ = 0; asm volatile("" : "+v"(wo_)); f32x16 sc; idx_scores(sc, kif, qi, qt, whp + wo_);
                unsigned b16 = 0u;
                int lq_ = lane_in; asm volatile("" : "+v"(lq_));
                const int lim = 32 * qb + (lq_ & 31) - 32 * kt - 8 * (lq_ >> 5), kbase = 8191 - 32 * kt - 8 * (lq_ >> 5);
                unsigned c16 = 0u;
#pragma unroll
                for (int r = 0; r < 16; ++r) { const int bin = (int)(sortable_u(sc[r]) >> 21);
                    b16 |= bin > tb ? 1u << r : 0u; c16 |= bin == tb ? 1u << r : 0u; }
                {
                  unsigned okm = 0xffffu;
                  if (kt == qb) { const int ld = (lq_ & 31) - 8 * (lq_ >> 5);
                      const unsigned lo8 = ld < 0 ? 0u : (ld >= 7 ? 0xffu : (2u << ld) - 1u), l2 = ld - 16; const unsigned hi8 = (int)l2 < 0 ? 0u : ((int)l2 >= 7 ? 0xffu : (2u << l2) - 1u);
                      okm = lo8 | (hi8 << 8); }
                  b16 &= okm; c16 &= okm; }
                if (c16 != 0u) {
                    unsigned pos = atomicAdd((unsigned*)&cnt[n], (unsigned)__builtin_popcount(c16));
#pragma unroll
                    for (int r = 0; r < 16; ++r) if ((c16 >> r) & 1u) {
                        if (pos < (unsigned)DSA_CAP) *(LAS u64*)(lds + DL_CAND + ((size_t)n * DSA_CAP + pos) * 8) = ((u64)sortable_u(sc[r]) << 13) | (u64)(kbase - (16 * (r >> 3) + (r & 7)));
                        ++pos; } }
                unsigned mw = ((b16 & 0xffu) << (8 * hi)) | ((b16 >> 8) << (16 + 8 * hi));
                mw |= (unsigned)__builtin_amdgcn_ds_bpermute((lane ^ 32) << 2, (int)mw);
                if (hi == 0) maskw[kt * 32 + n] = mw;
               }
              } }
            }
            asm volatile("s_waitcnt vmcnt(0)" ::: "memory");
            __syncthreads();
#pragma unroll 1
            for (int rp = 0; rp < 2; ++rp) {
                int ln = lane_in; asm volatile("" : "+v"(ln));
                int tb[2], c[2], nd[2]; u64 pref[2]; u64 kk[2][9];
#pragma unroll
                for (int q = 0; q < 2; ++q) { const int row = wave * 4 + 2 * rp + q; tb[q] = thrbin[row];
                    c[q] = tb[q] < 0 ? 0 : min((int)cnt[row], DSA_CAP); nd[q] = need[row]; if (nd[q] > c[q]) nd[q] = c[q];
                    pref[q] = (u64)(unsigned)(tb[q] < 0 ? 0 : tb[q]) << 34;
                    const LAS u64* cl = (const LAS u64*)(lds + DL_CAND) + (size_t)row * DSA_CAP;
#pragma unroll
                    for (int j = 0; j < 9; ++j) { const int e = ln + 64 * j; const u64 k = cl[e < c[q] ? e : ln]; kk[q][j] = e < c[q] ? k : 0ull; } }
                if (c[0] == 0 && c[1] == 0) continue;
#pragma unroll
                for (int ps = 0; ps < 5; ++ps) {
                    const int sh = ps == 0 ? 27 : ps == 1 ? 20 : ps == 2 ? 13 : ps == 3 ? 6 : 0, nbt = ps == 4 ? 6 : 7;
                    int b1[2], b0[2];
#pragma unroll
                    for (int q = 0; q < 2; ++q) { LAS unsigned* wh = (LAS unsigned*)(lds + DL_WHIST + (wave * 2 + q) * 512); wh[ln] = 0u; wh[ln + 64] = 0u; }
#pragma unroll
                    for (int q = 0; q < 2; ++q) { LAS unsigned* wh = (LAS unsigned*)(lds + DL_WHIST + (wave * 2 + q) * 512);
#pragma unroll
                        for (int j = 0; j < 9; ++j) { const u64 k = kk[q][j]; if (ln + 64 * j < c[q] && (k >> (sh + nbt)) == (pref[q] >> (sh + nbt))) atomicAdd((unsigned*)&wh[(unsigned)(k >> sh) & ((1u << nbt) - 1u)], 1u); } }
#pragma unroll
                    for (int q = 0; q < 2; ++q) { const LAS unsigned* wh = (const LAS unsigned*)(lds + DL_WHIST + (wave * 2 + q) * 512); b1[q] = (int)wh[127 - 2 * ln]; b0[q] = (int)wh[126 - 2 * ln]; }
                    int v0 = b1[0] + b0[0], v1 = b1[1] + b0[1]; const int x0 = v0, x1 = v1;
#pragma unroll
                    for (int d = 1; d < 64; d <<= 1) { const int o0 = __builtin_amdgcn_ds_bpermute((ln - d) << 2, v0), o1 = __builtin_amdgcn_ds_bpermute((ln - d) << 2, v1); if (ln >= d) { v0 += o0; v1 += o1; } }
                    const int pre[2] = {v0 - x0, v1 - x1}, cl2[2] = {x0, x1};
#pragma unroll
                    for (int q = 0; q < 2; ++q) {
                        int dig = -1, used = 0;
                        if (pre[q] < nd[q] && pre[q] + cl2[q] >= nd[q]) { if (pre[q] + b1[q] >= nd[q]) { dig = 127 - 2 * ln; used = pre[q]; } else { dig = 126 - 2 * ln; used = pre[q] + b1[q]; } }
                        const u64 ball = __ballot(dig >= 0); const int src = (int)__builtin_ctzll(ball | (1ull << 63));
                        dig = __builtin_amdgcn_readlane(dig, src); used = __builtin_amdgcn_readlane(used, src);
                        if (dig < 0) dig = 0;
                        pref[q] |= (u64)(unsigned)dig << sh; nd[q] -= used; }
                }
#pragma unroll
                for (int q = 0; q < 2; ++q) { const int row = wave * 4 + 2 * rp + q;
#pragma unroll
                    for (int j = 0; j < 9; ++j) { const u64 k = kk[q][j]; if (ln + 64 * j < c[q] && k >= pref[q]) { const int key = 8191 - (int)(k & 8191u); atomicOr((unsigned*)&maskw[(key >> 5) * 32 + row], 1u << (key & 31)); } } }
            }
            }
            __syncthreads();
        }
    }
    __syncthreads();
}
DI float wave_max_l(float v, int lane) {
#pragma unroll
    for (int o = 32; o > 0; o >>= 1) v = fmaxf(v, shfl_xor_l(v, o, lane));
    return v;
}
DI void wave_merge_store_l(float m, float l, float* o, bf16_t* out, int lane) {
    const float mall = wave_max_l(m, lane); const float f = exp2f(m - mall);
    l = wave_sum_l(l * f, lane); const float inv = 1.f / l;
    float mine = 0.f;
#pragma unroll
    for (int d = 0; d < 64; ++d) { const float v = wave_sum_l(o[d] * f, lane); if (lane == d) mine = v; }
    out[lane] = f2bf(mine * inv);
}
DI void nphase_mla(const Bufs& B, int gw, int NGW, int lane) {
    for (size_t task = gw; task < (size_t)M * 4; task += NGW) {
        const size_t row = task >> 2; const int h = (int)(task & 3); const int b = (int)(row / S), t = (int)(row % S);
        float q[96]; load_q<96>(q, B.QM() + (row * 4 + h) * 96);
        float m = -1e30f, l = 0.f, o[64];
#pragma unroll
        for (int d = 0; d < 64; ++d) o[d] = 0.f;
        for (int s = lane; s <= t; s += 64) {
            const size_t kr = (size_t)b * S + s;
            const float sc = dot_bf16<96>(q, B.KM() + (kr * 4 + h) * 96);
            const float mn = fmaxf(m, sc), a = exp2f(m - mn), p = exp2f(sc - mn);
            l = l * a + p; acc_v64(o, a, p, B.VM() + (kr * 4 + h) * 64); m = mn;
        }
        wave_merge_store_l(m, l, o, B.MIX() + row * D + h * 64, lane);
    }
}
DI void nphase_dil(const Bufs& B, int gw, int NGW, int lane) {
    for (size_t task = gw; task < (size_t)M * 8; task += NGW) {
        const size_t row = task >> 3; const int h = (int)(task & 7); const int b = (int)(row / S), t = (int)(row % S);
        float q[64]; load_q<64>(q, B.DQ() + (row * 8 + h) * 64);
        float m = -1e30f, l = 0.f, o[64];
#pragma unroll
        for (int d = 0; d < 64; ++d) o[d] = 0.f;
        for (int idx = lane; idx < 387; idx += 64) {
            const int p = idx / 129, j = idx % 129; const int dil = p == 0 ? 1 : (p == 1 ? 4 : 16);
            const int s = t - j * dil;
            if (s >= 0) {
                const size_t kr = (size_t)b * S + s;
                const float sc = dot_bf16<64>(q, B.DK() + (kr * 8 + h) * 64);
                const float mn = fmaxf(m, sc), a = exp2f(m - mn), pp = exp2f(sc - mn);
                l = l * a + pp; acc_v64(o, a, pp, B.DV() + (kr * 8 + h) * 64); m = mn;
            }
        }
        wave_merge_store_l(m, l, o, B.MIX() + row * D + 256 + h * 64, lane);
    }
}
DI void nphase_dsa(const Bufs& B, LAS unsigned char* lds, int G, int wave, int lane) {
    LAS float* sc = (LAS float*)lds;
    LAS float* qi = (LAS float*)(lds + 32768);
    LAS unsigned* hist = (LAS unsigned*)(lds + 32768 + 1024);
    LAS float* wsh = (LAS float*)(lds + 32768 + 2048);
    LAS unsigned* sv = (LAS unsigned*)(lds + 32768 + 2048 + 64);
    const int tid = wave * 64 + lane;
    for (int row_i = blockIdx.x; row_i < M; row_i += G) {
        const size_t row = row_i; const int b = (int)(row / S), t = (int)(row % S), n = t + 1;
        __syncthreads();
        if (tid < 256) qi[tid] = bf2f(B.QI()[row * 256 + tid]);
        if (tid < 8) wsh[tid] = B.WI()[row * 8 + tid];
        __syncthreads();
        for (int s = tid; s < n; s += NTHR) {
            float k[32]; load_q<32>(k, B.KI() + ((size_t)b * S + s) * 32);
            float score = 0.f;
#pragma unroll 1
            for (int h = 0; h < 8; ++h) { float d = 0.f;
#pragma unroll
                for (int dd = 0; dd < 32; ++dd) d += qi[h * 32 + dd] * k[dd];
                score += wsh[h] * fmaxf(d, 0.f); }
            sc[s] = score;
        }
        __syncthreads();
        u64 thr = 0ull;
        if (n > 256) {
            if (tid == 0) { unsigned z_ = 0u, n_ = 256u; asm volatile("" : "+v"(z_), "+v"(n_)); sv[0] = z_; sv[1] = z_; sv[2] = n_; }
            for (int p = 5; p >= 0; --p) {
                const int shift = 8 * p;
                if (tid < 256) hist[tid] = 0u;
                __syncthreads();
                const u64 pref = ((u64)sv[1] << 32) | sv[0];
                for (int s = tid; s < n; s += NTHR) { const u64 key = ((u64)sortable(sc[s]) << 13) | (u64)(8191 - s);
                    if ((key >> (shift + 8)) == (pref >> (shift + 8))) atomicAdd((unsigned*)&hist[(unsigned)(key >> shift) & 255u], 1u); }
                __syncthreads();
                if (tid == 0) { unsigned need = sv[2], cum = 0u; int dg = 255;
                    for (; dg > 0; --dg) { const unsigned c = hist[dg]; if (cum + c >= need) break; cum += c; }
                    const u64 np = pref | ((u64)dg << shift); sv[0] = (unsigned)np; sv[1] = (unsigned)(np >> 32); sv[2] = need - cum; }
                __syncthreads();
            }
            thr = ((u64)sv[1] << 32) | sv[0];
        }
        if (wave < 4) {
            const int h = wave;
            float q[64]; load_q<64>(q, B.SQ() + (row * 4 + h) * 64);
            float m = -1e30f, l = 0.f, o[64];
#pragma unroll
            for (int d = 0; d < 64; ++d) o[d] = 0.f;
            for (int s = lane; s < n; s += 64) {
                const u64 key = ((u64)sortable(sc[s]) << 13) | (u64)(8191 - s);
                if (key >= thr) {
                    const size_t kr = (size_t)b * S + s;
                    const float s2 = dot_bf16<64>(q, B.SK() + (kr * 4 + h) * 64);
                    const float mn = fmaxf(m, s2), a = exp2f(m - mn), p = exp2f(s2 - mn);
                    l = l * a + p; acc_v64(o, a, p, B.SV() + (kr * 4 + h) * 64); m = mn;
                }
            }
            wave_merge_store_l(m, l, o, B.MIX() + row * D + 768 + h * 64, lane);
        }
    }
    __syncthreads();
}
struct Inputs { const float *x, *g_attn, *w_in, *g_q_lat, *w_uq, *g_kv_lat, *w_ukv, *w_o, *g_ffn, *w_up, *conv_w, *conv_b, *w_down, *g_final; };
struct MkArgs { Bufs B; Inputs I; int ph_lo, ph_hi, use_bar, pad; };

DI Inputs load_inputs() { const __attribute__((address_space(4))) char* ka = (const __attribute__((address_space(4))) char*)__builtin_amdgcn_kernarg_segment_ptr(); asm volatile("" : "+s"(ka));
    typedef const float* fptr_t; const __attribute__((address_space(4))) fptr_t* pp = (const __attribute__((address_space(4))) fptr_t*)(ka + __builtin_offsetof(MkArgs, I));
    Inputs r; fptr_t* rp = (fptr_t*)&r;
#pragma unroll
    for (int i = 0; i < 14; ++i) rp[i] = pp[i];
    return r; }
constexpr int WK_N[5] = {NINP, NLAT, D, NUP, D};
constexpr int WK_K[5] = {D, KLAT, D, D, DFF};
DI float wval(const Inputs& I, int kind, int l, int n, int k, int up_perm) {
    switch (kind) {
        case 0: { const int sc = src_in(n, 1); return sc < 0 ? 0.f : I.w_in[((size_t)l * D + k) * NIN + sc] * I.g_attn[l * D + k]; }
        case 1: {
            if (n < 384) { if (k >= 256) return 0.f; int sc = n; if ((n % 96) >= 64) { const int g = n & ~31, ch = (n >> 2) & 7, e = n & 3; sc = g + 4 * ((ch >> 1) + 4 * (ch & 1)) + e; }
                return I.w_uq[((size_t)l * 256 + k) * 384 + sc] * I.g_q_lat[l * 256 + k]; }
            if (n < 896) { if (k < 256) return 0.f; return I.w_ukv[((size_t)l * 128 + (k - 256)) * 512 + (n - 384)] * I.g_kv_lat[l * 128 + (k - 256)]; }
            return 0.f; }
        case 2: return I.w_o[((size_t)l * D + k) * D + n];
        case 3: { int sc = n; if (up_perm) { const int pn = n >> 8, j = n & 255; sc = j < 128 ? 128 * pn + j : DFF + 128 * pn + (j - 128); } return I.w_up[((size_t)l * D + k) * NUP + sc] * I.g_ffn[l * D + k]; }
        default: return I.w_down[((size_t)l * DFF + k) * D + n];
    }
}
DI bf16_t* wptr(const Bufs& B, int l, int kind) {
    bf16_t* p = B.W() + (size_t)l * W_LAYER;
    if (kind >= 1) p += W_IN; if (kind >= 2) p += W_LAT; if (kind >= 3) p += W_O; if (kind >= 4) p += W_UP;
    return p;
}

DI void phase_prologue(const Bufs& B, const Inputs& I, LAS unsigned char* lds, int gw, int NGW, int wave, int lane, int up_perm) {
    for (int idx = gw * 64 + lane; idx < S * 28; idx += NGW * 64) {
        const int t = idx / 28, i = idx % 28;
        if (i < 16) { const float inv = powf(THETA, -(float)(2 * i) / 32.0f); const float a = (float)t * inv; B.cosA()[t * 16 + i] = cosf(a); B.sinA()[t * 16 + i] = sinf(a); }
        else if (i < 24) { const int j = i - 16; const float inv = powf(THETA, -(float)(2 * j) / 16.0f); const float a = (float)t * inv; B.cosH()[t * 8 + j] = cosf(a); B.sinH()[t * 8 + j] = sinf(a); }
        else { const int j = i - 24; const float inv = powf(THETA, -(float)(2 * j) / 8.0f); const float a = (float)t * inv; B.cosI()[t * 4 + j] = cosf(a); B.sinI()[t * 4 + j] = sinf(a); }
    }
    LAS float* scr = (LAS float*)(lds + LDS_STAGE + wave * 8704);
    int items_per_layer = 0;
#pragma unroll
    for (int kd = 0; kd < 5; ++kd) items_per_layer += (WK_N[kd] / 32) * (WK_K[kd] / 64);
#ifndef REP_PRO_W
#define REP_PRO_W 1
#endif
#ifndef REP_PRO_X
#define REP_PRO_X 1
#endif
    for (int rw_ = 0; rw_ < REP_PRO_W; ++rw_)
    for (int it = gw; it < items_per_layer * NL; it += NGW) {
        const int l = it / items_per_layer; int r = it % items_per_layer; int kind = 0;
#pragma unroll
        for (int kd = 0; kd < 4; ++kd) { const int cnt = (WK_N[kd] / 32) * (WK_K[kd] / 64); if (kind == kd && r >= cnt) { r -= cnt; kind = kd + 1; } }
        const int K = kind == 0 ? WK_K[0] : kind == 1 ? WK_K[1] : kind == 2 ? WK_K[2] : kind == 3 ? WK_K[3] : WK_K[4];
        const int N_ = kind == 0 ? WK_N[0] : kind == 1 ? WK_N[1] : kind == 2 ? WK_N[2] : kind == 3 ? WK_N[3] : WK_N[4];
        const int nnb = N_ / 32, nb = r % nnb, kb = r / nnb, n0 = nb * 32, k0 = kb * 64;
        { const int n = n0 + (lane & 31); const float* src; const float* gp = nullptr; int ld, col = n, koff = 0; bool iv = true; float lanev = 1.f;
          if (kind == 0) { const int sc = src_in(n, 1); col = sc < 0 ? 0 : sc; lanev = sc < 0 ? 0.f : 1.f; src = I.w_in + (size_t)l * D * NIN; ld = NIN; gp = I.g_attn + l * D; }
          else if (kind == 1) {
              if (n0 < 384) { iv = k0 < 256; if ((n % 96) >= 64) { const int g = n & ~31, ch = (n >> 2) & 7, e = n & 3; col = g + 4 * ((ch >> 1) + 4 * (ch & 1)) + e; }
                  src = I.w_uq + (size_t)l * 256 * 384; ld = 384; gp = I.g_q_lat + l * 256; }
              else if (n0 < 896) { iv = k0 >= 256; koff = -256; col = n - 384; src = I.w_ukv + (size_t)l * 128 * 512; ld = 512; gp = I.g_kv_lat + l * 128; }
              else { iv = false; src = I.w_uq; ld = 384; } }
          else if (kind == 2) { src = I.w_o + (size_t)l * D * D; ld = D; }
          else if (kind == 3) { if (up_perm) { const int pn = n >> 8, j = n & 255; col = j < 128 ? 128 * pn + j : DFF + 128 * pn + (j - 128); } src = I.w_up + (size_t)l * D * NUP; ld = NUP; gp = I.g_ffn + l * D; }
          else { src = I.w_down + (size_t)l * DFF * D; ld = D; }
          const int kb0 = k0 + koff + (lane >> 5);
          if (!iv) {
#pragma unroll
              for (int i = 0; i < 32; ++i) scr[(2 * i + (lane >> 5)) * 33 + (lane & 31)] = 0.f;
          } else if (gp) {
              float v[32], g[32];
#pragma unroll
              for (int i = 0; i < 32; ++i) { v[i] = src[(size_t)(kb0 + 2 * i) * ld + col]; g[i] = gp[kb0 + 2 * i]; }
#pragma unroll
              for (int i = 0; i < 32; ++i) scr[(2 * i + (lane >> 5)) * 33 + (lane & 31)] = v[i] * g[i] * lanev;
          } else {
              float v[32];
#pragma unroll
              for (int i = 0; i < 32; ++i) v[i] = src[(size_t)(kb0 + 2 * i) * ld + col];
#pragma unroll
              for (int i = 0; i < 32; ++i) scr[(2 * i + (lane >> 5)) * 33 + (lane & 31)] = v[i];
          } }
        asm volatile("s_waitcnt lgkmcnt(0)" ::: "memory");
        bf16_t* out = wptr(B, l, kind);
        const int c = lane & 7;
#pragma unroll
        for (int j = 0; j < 4; ++j) { const int n = (lane >> 3) + 8 * j; const LAS float* s = scr + (8 * c) * 33 + n;
            u32x4 o; o.x = pk2(s[0 * 33], s[1 * 33]); o.y = pk2(s[2 * 33], s[3 * 33]); o.z = pk2(s[4 * 33], s[5 * 33]); o.w = pk2(s[6 * 33], s[7 * 33]);
            *(u32x4*)(out + (size_t)(n0 + n) * K + k0 + 8 * c) = o; }
        asm volatile("s_waitcnt lgkmcnt(0)" ::: "memory");
    }
    for (int rx_ = 0; rx_ < REP_PRO_X; ++rx_)
    for (int row0 = gw; row0 < M; row0 += 2 * NGW) {
        const bool two = row0 + NGW < M; const int row1 = two ? row0 + NGW : row0;
        const f32x4* xa = (const f32x4*)(I.x + (size_t)row0 * D) + lane; const f32x4* xb = (const f32x4*)(I.x + (size_t)row1 * D) + lane;
        f32x4 va[4], vb[4]; float sa = 0.f, sb = 0.f;
#pragma unroll
        for (int j = 0; j < 4; ++j) { va[j] = xa[64 * j]; vb[j] = xb[64 * j]; }
#pragma unroll
        for (int j = 0; j < 4; ++j) { sa += (va[j][0] * va[j][0] + va[j][1] * va[j][1]) + (va[j][2] * va[j][2] + va[j][3] * va[j][3]); sb += (vb[j][0] * vb[j][0] + vb[j][1] * vb[j][1]) + (vb[j][2] * vb[j][2] + vb[j][3] * vb[j][3]); }
        sa = wave_sum_l(sa, lane); sb = wave_sum_l(sb, lane);
#pragma unroll
        for (int j = 0; j < 4; ++j) { ((f32x4*)(B.X() + (size_t)row0 * D))[lane + 64 * j] = va[j]; ((u32x2*)(B.XB() + (size_t)row0 * D))[lane + 64 * j] = pk4(va[j]); }
        if (lane < 4) B.RSP()[(size_t)row0 * 4 + lane] = lane == 0 ? sa : 0.f;
        if (two) {
#pragma unroll
            for (int j = 0; j < 4; ++j) { ((f32x4*)(B.X() + (size_t)row1 * D))[lane + 64 * j] = vb[j]; ((u32x2*)(B.XB() + (size_t)row1 * D))[lane + 64 * j] = pk4(vb[j]); }
            if (lane < 4) B.RSP()[(size_t)row1 * 4 + lane] = lane == 0 ? sb : 0.f; }
    }
}

DI void phase_final(const Bufs& B, const float* g_final, int gw, int NGW, int lane) {
    for (int row = gw; row < M; row += NGW) {
        const float rs = rs_of(B.RSP(), (size_t)row);
        f32x4* xr = (f32x4*)(B.X() + (size_t)row * D) + lane; const f32x4* gr = (const f32x4*)g_final + lane;
#pragma unroll
        for (int j = 0; j < 4; ++j) xr[64 * j] = xr[64 * j] * rs * gr[64 * j];
    }
}

#ifndef REP_P1
#define REP_P1 1
#endif
#ifndef REP_LAT
#define REP_LAT 1
#endif
#ifndef REP_DIL
#define REP_DIL 1
#endif
#ifndef REP_DSA
#define REP_DSA 1
#endif
#ifndef REP_MLA
#define REP_MLA 1
#endif
#ifndef REP_P5
#define REP_P5 1
#endif
__global__ void __launch_bounds__(NTHR, 2) mk(MkArgs A) {
    extern __shared__ __attribute__((aligned(16))) unsigned char lds_raw[];
    LAS unsigned char* lds = (LAS unsigned char*)lds_raw;
    const int wave = __builtin_amdgcn_readfirstlane(threadIdx.x >> 6);
    const int G = gridDim.x, NGW = G * NWAVES;
    volatile LAS unsigned* misc = (volatile LAS unsigned*)(lds + LDS_MISC);
    if (wave == 0 && lane_id() < 16) misc[lane_id()] = 0u;
    __syncthreads();
#define IS_T0 ((wave * 64 + lane_id()) == 0)
    XcdBarrier bar; bar.bar = A.B.CTL() + 1024; bar.x = 0; bar.st = misc;
    if (A.use_bar) bar = xcd_barrier_post(A.B.CTL() + 1024, misc, IS_T0);
    const int lo = A.ph_lo, hi = A.ph_hi;
#define IN(k) (lo <= (k) && (k) < hi)
#ifndef REP_SEAM
#define REP_SEAM 1
#endif
#define SEAM(k) do { if (IN(k) && IN((k) + 1)) { XcdBarrier bb_ = bar; size_t z_ = 0; asm volatile("" : "+s"(z_)); bb_.bar = A.B.CTL() + 1024 + z_; for (int rs_ = 0; rs_ < REP_SEAM; ++rs_) xcd_barrier(bb_, IS_T0); } } while (0)
#define OPAQUE_BUFS(Bl) Bufs Bl = A.B; { size_t z_ = 0; asm volatile("" : "+s"(z_)); Bl.ws += z_; Bl.Xp = (float*)((char*)Bl.Xp + z_); }
#ifndef REP_PRO
#define REP_PRO 1
#endif
    for (int rep_ = 0; rep_ < REP_PRO; ++rep_) if (IN(0)) { int l_ = lane_id(); asm volatile("" : "+v"(l_)); const Inputs I_ = load_inputs(); phase_prologue(A.B, I_, lds, blockIdx.x * NWAVES + wave, NGW, wave, l_, UP_PERM); } SEAM(0);
    for (int l = 0; l < NL; ++l) {
        const int pb = 1 + 6 * l;
        for (int rep_ = 0; rep_ < REP_P1; ++rep_) if (IN(pb + 0)) {
            OPAQUE_BUFS(Bl);
            pg8::Gemm g{Bl.XB(), wptr(Bl, l, 0), M, NINP, D}; pg8::GridOrder So; So.init(M / 256, NINP / 256, G, (int)blockIdx.x);
            EpiInproj E{Bl, (LAS float*)(lds + LDS_HALO)};
            pg8::gemm_phase<EpiInproj, pg8::GridOrder, true, true>(lds + LDS_STAGE, g, So, E, wave);
        } SEAM(pb + 0);
        for (int rep_ = 0; rep_ < REP_LAT; ++rep_) if (IN(pb + 1)) {
            OPAQUE_BUFS(Bl);
            int klat = KLAT; asm volatile("" : "+s"(klat));
            pg8::Gemm g{Bl.CQKV(), wptr(Bl, l, 1), M, NLAT, klat}; pg8::GridOrder So; So.init(M / 256, NLAT / 256, G, (int)blockIdx.x);
            EpiLat E{Bl, (LAS float*)(lds + LDS_HALO)};
            pg8::gemm_phase<EpiLat, pg8::GridOrder, true, true>(lds + LDS_STAGE, g, So, E, wave);
        }
        if (IN(pb + 1)) {
            OPAQUE_BUFS(Bl); int l_ = lane_id(); asm volatile("" : "+v"(l_));
            for (int rep_ = 0; rep_ < REP_DIL; ++rep_) phase_dil2(Bl, lds, G, wave, l_);
            for (int rep_ = 0; rep_ < REP_DSA; ++rep_) phase_dsa(Bl, lds, G, wave, l_);
        }
        SEAM(pb + 1);
        if (IN(pb + 2)) { OPAQUE_BUFS(Bl); int l_ = lane_id(); asm volatile("" : "+v"(l_)); for (int rep_ = 0; rep_ < REP_MLA; ++rep_) phase_attn_shared(Bl, lds, G, wave, l_, rep_ > 0 ? ATT_VARIANT : 0); }
        SEAM(pb + 2);
#ifndef REP_P4
#define REP_P4 0
#endif
#ifndef REP_P6
#define REP_P6 0
#endif
        for (int rep_ = 0; rep_ < REP_P4; ++rep_) if (IN(pb + 3)) {
            OPAQUE_BUFS(Bl);
            pg8::Gemm g{Bl.MIX(), wptr(Bl, l, 2), M, D, D}; pg8::GridOrder So; So.init(M / 256, D / 256, G, (int)blockIdx.x);
            EpiResidT<true> E{Bl, (LAS float*)(lds + LDS_HALO)};
            pg8::gemm_phase<EpiResidT<true>, pg8::GridOrder, true, true>(lds + LDS_STAGE, g, So, E, wave);
        }
        if (IN(pb + 3)) {
            OPAQUE_BUFS(Bl);
            pg8::Gemm g{Bl.MIX(), wptr(Bl, l, 2), M, D, D}; pg8::GridOrder So; So.init(M / 256, D / 256, G, (int)blockIdx.x);
            EpiResid E{Bl, (LAS float*)(lds + LDS_HALO)};
            pg8::gemm_phase<EpiResid, pg8::GridOrder, true, true>(lds + LDS_STAGE, g, So, E, wave);
        } SEAM(pb + 3);
        for (int rep_ = 0; rep_ < REP_P5; ++rep_) if (IN(pb + 4)) {
            OPAQUE_BUFS(Bl);
            pg8::Gemm g{Bl.XB(), wptr(Bl, l, 3), M, NUP, D}; pg8::GridOrder So; So.init(M / 256, NUP / 256, G, (int)blockIdx.x);
            const Inputs I_ = load_inputs(); EpiConvAct E{Bl, I_.conv_w + (size_t)l * 3 * NUP, I_.conv_b + (size_t)l * NUP, (LAS float*)(lds + LDS_HALO)};
            pg8::gemm_phase<EpiConvAct, pg8::GridOrder, true, true>(lds + LDS_STAGE, g, So, E, wave);
        } SEAM(pb + 4);
        for (int rep_ = 0; rep_ < REP_P6; ++rep_) if (IN(pb + 5)) {
            OPAQUE_BUFS(Bl);
            pg8::Gemm g{Bl.ACT(), wptr(Bl, l, 4), M, D, DFF}; pg8::GridOrder So; So.init(M / 256, D / 256, G, (int)blockIdx.x);
            EpiResidT<true> E{Bl, (LAS float*)(lds + LDS_HALO)};
            pg8::gemm_phase<EpiResidT<true>, pg8::GridOrder, true, true>(lds + LDS_STAGE, g, So, E, wave);
        }
        if (IN(pb + 5)) {
            OPAQUE_BUFS(Bl);
            pg8::Gemm g{Bl.ACT(), wptr(Bl, l, 4), M, D, DFF}; pg8::GridOrder So; So.init(M / 256, D / 256, G, (int)blockIdx.x);
            {
              const Inputs I_ = load_inputs(); int l2_ = lane_id(); asm volatile("" : "+v"(l2_)); int lastpm = -1;
#pragma unroll 1
              for (int i = 0;; ++i) { int pmi; { pg8::Unit uu; pmi = So.next(i, uu) ? uu.pm : -1; }
                  if (pmi < 0) break;
                  if (pmi != lastpm) { conv_fixup(Bl, I_.conv_w + (size_t)l * 3 * NUP, I_.conv_b + (size_t)l * NUP, pmi, wave * 64 + l2_); lastpm = pmi; } }
              asm volatile("s_waitcnt vmcnt(0)" ::: "memory"); __syncthreads(); }
            EpiResid E{Bl, (LAS float*)(lds + LDS_HALO)};
            pg8::gemm_phase<EpiResid, pg8::GridOrder, true, true>(lds + LDS_STAGE, g, So, E, wave);
        } SEAM(pb + 5);
    }
    if (IN(25)) { int l_ = lane_id(); asm volatile("" : "+v"(l_)); const Inputs I_ = load_inputs(); phase_final(A.B, I_.g_final, blockIdx.x * NWAVES + wave, NGW, l_); }
#undef IN
#undef SEAM
#undef OPAQUE_BUFS
#undef IS_T0
}
extern "C" void kernel_launch(void* const* d_in, const int* in_sizes, int n_in, void* d_out, int out_size, void* d_ws, size_t ws_size, hipStream_t stream) {
    static int grid = 0;
    if (grid == 0) {
        int dev = 0, cus = 0, per_cu = 0; (void)hipGetDevice(&dev); (void)hipDeviceGetAttribute(&cus, hipDeviceAttributeMultiprocessorCount, dev);
        (void)hipFuncSetAttribute((const void*)mk, hipFuncAttributeMaxDynamicSharedMemorySize, LDS_BYTES);
        (void)hipOccupancyMaxActiveBlocksPerMultiprocessor(&per_cu, (const void*)mk, NTHR, LDS_BYTES);
        (void)hipGetLastError();
        grid = cus > 0 ? cus : 256;
    }
    MkArgs A{};
    A.B = make_bufs(d_out, d_ws);
    const float** ip = (const float**)&A.I;
    for (int i = 0; i < 14; ++i) ip[i] = (const float*)d_in[i];
    (void)hipMemsetAsync((char*)d_ws + OFF_CTL, 0, CTL_BYTES, stream);
    A.ph_lo = 0; A.ph_hi = 26; A.use_bar = 1; A.pad = 0;
    hipLaunchKernelGGL(mk, dim3(grid), dim3(NTHR), LDS_BYTES, stream, A);
}
```
